# Optimizing an MI355X kernel written in HIP

```python
import jax
import jax.numpy as jnp
from jax import lax
import numpy as np

D_MODEL = 1024
BATCH = 16
SEQ = 2048
DEPTH = 2

GRID_W = 64
CTX_LEN = 256
EPS = 1e-6
N_MOD = 6

LRU_WIDTH = 512
LRU_HEADS = 8
LRU_HEAD_DIM = LRU_WIDTH // LRU_HEADS
LRU_CONV_W = 4
LRU_CONV_PAD = (LRU_CONV_W // 2, LRU_CONV_W - 1 - LRU_CONV_W // 2)
LRU_C = 8.0

N_HEADS = 8
N_KV_HEADS = 2
HEAD_DIM = 64
WINDOW = 128
ATT_BLOCK = 128
ROPE_BASE = 10000.0
Q_WIDTH = N_HEADS * HEAD_DIM
KV_WIDTH = N_KV_HEADS * HEAD_DIM
AB_IN = 2 * LRU_WIDTH + Q_WIDTH + 2 * KV_WIDTH
AB_OUT = LRU_WIDTH + Q_WIDTH

CONV_K = 31
CONV_PAD = ((CONV_K - 1) // 2, (CONV_K - 1) // 2)

N_EXPERTS = 256
TOP_K = 8
N_GROUPS = 8
TOPK_GROUPS = 4
EXPERT_DIM = 256
SHARED_DIM = 256
ROUTED_SCALE = 2.5
MOE_BLOCK = 256

N_EVEN = (DEPTH + 1) // 2
N_ODD = DEPTH // 2

kernel_name = 'hybrid_rglru_swa_conformer_moe_dit'


def _rmsnorm(x, g):
    x32 = x.astype(jnp.float32)
    y = x32 * lax.rsqrt(jnp.mean(x32 * x32, axis=-1, keepdims=True) + EPS)
    return (y * g.astype(jnp.float32)).astype(x.dtype)


def _modulate(h, shift, scale):
    return h * (1 + scale) + shift


def _dwconv(x, w, b, pad):
    y = lax.conv_general_dilated(x, w[:, None, :].astype(x.dtype), window_strides=(1,), padding=[pad],
                                 dimension_numbers=('NWC', 'WIO', 'NWC'), feature_group_count=x.shape[-1])
    return y + b


def _axial_rope_tables(n_tokens):
    rows = n_tokens // GRID_W
    row = jnp.repeat(jnp.arange(rows, dtype=jnp.float32), GRID_W)
    col = jnp.tile(jnp.arange(GRID_W, dtype=jnp.float32), rows)
    n_freq = HEAD_DIM // 4
    inv = ROPE_BASE ** (-jnp.arange(n_freq, dtype=jnp.float32) / n_freq)
    ang_r = row[:, None] * inv
    ang_c = col[:, None] * inv
    return (jnp.cos(ang_r), jnp.sin(ang_r), jnp.cos(ang_c), jnp.sin(ang_c))


def _rotate(x, cos, sin):
    x1, x2 = jnp.split(x, 2, axis=-1)
    cos = cos[:, None, :]
    sin = sin[:, None, :]
    return jnp.concatenate([x1 * cos - x2 * sin, x2 * cos + x1 * sin], axis=-1)


def _apply_axial_rope(x, tables):
    cos_r, sin_r, cos_c, sin_c = tables
    x32 = x.astype(jnp.float32)
    half = x.shape[-1] // 2
    out = jnp.concatenate([_rotate(x32[..., :half], cos_r, sin_r),
                           _rotate(x32[..., half:], cos_c, sin_c)], axis=-1)
    return out.astype(x.dtype)


def _rglru_coeffs(u, w_r, b_r, w_i, b_i, lam):
    bsz, n, width = u.shape
    uh = u.reshape(bsz, n, LRU_HEADS, LRU_HEAD_DIM)
    r = jax.nn.sigmoid(jnp.einsum('bshi,hij->bshj', uh, w_r).reshape(bsz, n, width) + b_r)
    i = jax.nn.sigmoid(jnp.einsum('bshi,hij->bshj', uh, w_i).reshape(bsz, n, width) + b_i)
    log_a = -LRU_C * r.astype(jnp.float32) * jax.nn.softplus(-lam.astype(jnp.float32))
    a = jnp.exp(log_a)
    b = jnp.sqrt(-jnp.expm1(2.0 * log_a)) * (i * u).astype(jnp.float32)
    return a, b


def _linear_scan(a, b, h0):
    b = b.at[:, 0].add(a[:, 0] * h0)

    def combine(left, right):
        return left[0] * right[0], right[0] * left[1] + right[1]

    return lax.associative_scan(combine, (a, b), axis=1)[1]


def _flip_if(t, rev):
    return jnp.flip(t, axis=1) if rev else t


def _bidir_rglru(u, uc, w_r, b_r, w_i, b_i, lam, with_ctx):
    outs, outs_c = [], []
    for d in range(2):
        rev = d == 1
        dc, ic = _rglru_coeffs(uc, w_r[d], b_r[d], w_i[d], b_i[d], lam[d])
        dx, ix = _rglru_coeffs(u, w_r[d], b_r[d], w_i[d], b_i[d], lam[d])
        h_c = _linear_scan(_flip_if(dc, rev), _flip_if(ic, rev), jnp.zeros((uc.shape[0], uc.shape[2]), jnp.float32))
        h_x = _linear_scan(_flip_if(dx, rev), _flip_if(ix, rev), h_c[:, -1])
        outs.append(_flip_if(h_x, rev))
        if with_ctx:
            outs_c.append(_flip_if(h_c, rev))
    y = (outs[0] + outs[1]).astype(u.dtype)
    yc = (outs_c[0] + outs_c[1]).astype(uc.dtype) if with_ctx else None
    return y, yc


def _window_attention_with_ctx(q, k, v, kc, vc, sink):
    bsz, n, _, hd = q.shape
    grp = N_HEADS // N_KV_HEADS
    nb = n // ATT_BLOCK
    scale = hd ** -0.5
    qb = q.reshape(bsz, nb, ATT_BLOCK, N_KV_HEADS, grp, hd)

    def band(t):
        tp = jnp.pad(t, ((0, 0), (ATT_BLOCK, ATT_BLOCK), (0, 0), (0, 0)))
        tp = tp.reshape(bsz, nb + 2, ATT_BLOCK, N_KV_HEADS, hd)
        return jnp.concatenate([tp[:, :-2], tp[:, 1:-1], tp[:, 2:]], axis=2)

    kw, vw = band(k), band(v)
    s_w = jnp.einsum('bnqkgd,bnjkd->bnkgqj', qb, kw).astype(jnp.float32) * scale
    s_c = jnp.einsum('bnqkgd,blkd->bnkgql', qb, kc).astype(jnp.float32) * scale
    qi = jnp.arange(ATT_BLOCK)[:, None]
    kj = jnp.arange(3 * ATT_BLOCK)[None, :]
    kpos = (jnp.arange(nb)[:, None, None] - 1) * ATT_BLOCK + kj
    mask = (jnp.abs(kj - qi - ATT_BLOCK) <= WINDOW) & (kpos >= 0) & (kpos < n)
    s_w = jnp.where(mask[None, :, None, None], s_w, -jnp.inf)
    sk = sink.astype(jnp.float32).reshape(1, 1, N_KV_HEADS, grp, 1, 1)
    m = jnp.maximum(jnp.maximum(s_w.max(-1, keepdims=True), s_c.max(-1, keepdims=True)), sk)
    p_w = jnp.exp(s_w - m)
    p_c = jnp.exp(s_c - m)
    denom = p_w.sum(-1, keepdims=True) + p_c.sum(-1, keepdims=True) + jnp.exp(sk - m)
    o = (jnp.einsum('bnkgqj,bnjkd->bnqkgd', (p_w / denom).astype(v.dtype), vw)
         + jnp.einsum('bnkgql,blkd->bnqkgd', (p_c / denom).astype(vc.dtype), vc))
    return o.reshape(bsz, n, N_HEADS * hd)


def _ctx_attention(qc, kc, vc, sink):
    bsz, n_ctx, _, hd = qc.shape
    grp = N_HEADS // N_KV_HEADS
    qg = qc.reshape(bsz, n_ctx, N_KV_HEADS, grp, hd)
    s = jnp.einsum('blkgd,bmkd->bkglm', qg, kc).astype(jnp.float32) * hd ** -0.5
    sk = sink.astype(jnp.float32).reshape(1, N_KV_HEADS, grp, 1, 1)
    m = jnp.maximum(s.max(-1, keepdims=True), sk)
    p = jnp.exp(s - m)
    p = p / (p.sum(-1, keepdims=True) + jnp.exp(sk - m))
    o = jnp.einsum('bkglm,bmkd->blkgd', p.astype(vc.dtype), vc)
    return o.reshape(bsz, n_ctx, N_HEADS * hd)


def _mixer_rglru_swa(h, hc, w_in, w_out, conv_w, conv_b, w_r, b_r, w_i, b_i, lam, sink, rope, with_ctx):
    bsz, n, _ = h.shape
    n_ctx = hc.shape[1]
    r0, r1, r2 = LRU_WIDTH, 2 * LRU_WIDTH, 2 * LRU_WIDTH + Q_WIDTH
    proj = h @ w_in
    u, g, q, kv = proj[..., :r0], proj[..., r0:r1], proj[..., r1:r2], proj[..., r2:]
    uc = hc @ w_in[:, :r0]
    kvc = hc @ w_in[:, r2:]
    u = _dwconv(u, conv_w, conv_b, LRU_CONV_PAD)
    uc = _dwconv(uc, conv_w, conv_b, LRU_CONV_PAD)
    rec, rec_c = _bidir_rglru(u, uc, w_r, b_r, w_i, b_i, lam, with_ctx)
    q = _apply_axial_rope(q.reshape(bsz, n, N_HEADS, HEAD_DIM), rope)
    k = _apply_axial_rope(kv[..., :KV_WIDTH].reshape(bsz, n, N_KV_HEADS, HEAD_DIM), rope)
    v = kv[..., KV_WIDTH:].reshape(bsz, n, N_KV_HEADS, HEAD_DIM)
    kc = kvc[..., :KV_WIDTH].reshape(bsz, n_ctx, N_KV_HEADS, HEAD_DIM)
    vc = kvc[..., KV_WIDTH:].reshape(bsz, n_ctx, N_KV_HEADS, HEAD_DIM)
    att = _window_attention_with_ctx(q, k, v, kc, vc, sink)
    y = jnp.concatenate([jax.nn.gelu(g) * rec, att], axis=-1) @ w_out
    if not with_ctx:
        return y, None
    gc = hc @ w_in[:, r0:r1]
    qc = (hc @ w_in[:, r1:r2]).reshape(bsz, n_ctx, N_HEADS, HEAD_DIM)
    att_c = _ctx_attention(qc, kc, vc, sink)
    yc = jnp.concatenate([jax.nn.gelu(gc) * rec_c, att_c], axis=-1) @ w_out
    return y, yc


def _conformer_conv(h, w_in, b_in, dw_w, dw_b, ln_g, ln_b, w_out, b_out):
    z = h @ w_in + b_in
    val, gt = jnp.split(z, 2, axis=-1)
    z = _dwconv(val * jax.nn.sigmoid(gt), dw_w, dw_b, CONV_PAD)
    z32 = z.astype(jnp.float32)
    mu = jnp.mean(z32, axis=-1, keepdims=True)
    var = jnp.mean(jnp.square(z32 - mu), axis=-1, keepdims=True)
    z = ((z32 - mu) * lax.rsqrt(var + EPS) * ln_g + ln_b).astype(h.dtype)
    return jax.nn.silu(z) @ w_out + b_out


def _routed_experts(t, idx, gate, w1, w3, w2):
    n_tok, d = t.shape
    n_assign = n_tok * TOP_K
    flat_e = idx.reshape(n_assign)
    order = jnp.argsort(flat_e)
    sorted_e = flat_e[order]
    sorted_tok = (order // TOP_K).astype(jnp.int32)
    sorted_gate = gate.reshape(n_assign)[order]
    counts = jnp.zeros((N_EXPERTS,), jnp.int32).at[flat_e].add(1)
    starts = jnp.cumsum(counts) - counts
    padded = (counts + MOE_BLOCK - 1) // MOE_BLOCK * MOE_BLOCK
    pad_ends = jnp.cumsum(padded)
    dest = pad_ends[sorted_e] - padded[sorted_e] + jnp.arange(n_assign) - starts[sorted_e]
    n_blk = -(-n_assign // MOE_BLOCK) + N_EXPERTS
    slot_tok = jnp.full((n_blk * MOE_BLOCK,), n_tok, jnp.int32).at[dest].set(sorted_tok)
    slot_gate = jnp.zeros((n_blk * MOE_BLOCK,), t.dtype).at[dest].set(sorted_gate)
    blk_e = jnp.minimum(jnp.searchsorted(pad_ends, jnp.arange(n_blk) * MOE_BLOCK, side='right'), N_EXPERTS - 1)
    t_pad = jnp.concatenate([t, jnp.zeros((1, d), t.dtype)], axis=0)

    def step(acc, blk):
        tok, g, e = blk
        rows = t_pad[tok]
        hid = jax.nn.silu(rows @ w1[e]) * (rows @ w3[e])
        return acc.at[tok].add((hid @ w2[e]) * g[:, None]), None

    acc, _ = lax.scan(step, jnp.zeros((n_tok + 1, d), t.dtype),
                      (slot_tok.reshape(n_blk, MOE_BLOCK), slot_gate.reshape(n_blk, MOE_BLOCK), blk_e))
    return acc[:n_tok]


def _moe(t, router_w, router_b, w1, w3, w2, sw1, sw3, sw2):
    n_tok = t.shape[0]
    scores = jax.nn.sigmoid((t @ router_w).astype(jnp.float32))
    biased = scores + router_b.astype(jnp.float32)
    grp = biased.reshape(n_tok, N_GROUPS, N_EXPERTS // N_GROUPS)
    grp_score = lax.top_k(grp, 2)[0].sum(-1)
    gidx = lax.top_k(grp_score, TOPK_GROUPS)[1]
    gmask = (gidx[..., None] == jnp.arange(N_GROUPS)).any(axis=-2)
    allowed = jnp.repeat(gmask, N_EXPERTS // N_GROUPS, axis=-1)
    eidx = lax.top_k(jnp.where(allowed, biased, -jnp.inf), TOP_K)[1]
    w = jnp.take_along_axis(scores, eidx, axis=-1)
    w = ROUTED_SCALE * w / jnp.sum(w, axis=-1, keepdims=True)
    routed = _routed_experts(t, eidx, w.astype(t.dtype), w1, w3, w2)
    shared = (jax.nn.silu(t @ sw1) * (t @ sw3)) @ sw2
    return routed + shared


def setup_inputs(seed: int = 0) -> dict:
    key = jax.random.key(seed)
    ks = iter(jax.random.split(key, 48))

    def nrm(shape, s):
        return jax.random.normal(next(ks), shape, jnp.float32) * s

    def gain(shape):
        return 1.0 + nrm(shape, 0.02)

    D = D_MODEL
    ac = jax.random.uniform(next(ks), (N_EVEN, 2, LRU_WIDTH), jnp.float32, 0.9, 0.999)
    a = ac ** (1.0 / LRU_C)
    lam = jnp.log(a) - jnp.log1p(-a)
    return {
        'x': nrm((BATCH, SEQ, D), 1.0),
        'c': nrm((BATCH, D), 1.0),
        'ctx': nrm((BATCH, CTX_LEN, D), 1.0),
        'c_ctx': nrm((D,), 1.0),
        'mod_w': nrm((DEPTH, D, N_MOD * D), 0.5 * D ** -0.5),
        'mod_b': nrm((DEPTH, N_MOD * D), 0.02),
        'norm_mix_g': gain((DEPTH, D)),
        'norm_ffn_g': gain((DEPTH, D)),
        'final_norm_g': gain((D,)),
        'ab_w_in': nrm((N_EVEN, D, AB_IN), D ** -0.5),
        'ab_w_out': nrm((N_EVEN, AB_OUT, D), AB_OUT ** -0.5),
        'lru_conv_w': nrm((N_EVEN, LRU_CONV_W, LRU_WIDTH), LRU_CONV_W ** -0.5),
        'lru_conv_b': nrm((N_EVEN, LRU_WIDTH), 0.02),
        'lru_wr': nrm((N_EVEN, 2, LRU_HEADS, LRU_HEAD_DIM, LRU_HEAD_DIM), LRU_HEAD_DIM ** -0.5),
        'lru_br': nrm((N_EVEN, 2, LRU_WIDTH), 0.02),
        'lru_wi': nrm((N_EVEN, 2, LRU_HEADS, LRU_HEAD_DIM, LRU_HEAD_DIM), LRU_HEAD_DIM ** -0.5),
        'lru_bi': nrm((N_EVEN, 2, LRU_WIDTH), 0.02),
        'lru_lambda': lam,
        'attn_sink': nrm((N_EVEN, N_HEADS), 0.5),
        'cm_w_in': nrm((N_ODD, D, 2 * D), D ** -0.5),
        'cm_b_in': nrm((N_ODD, 2 * D), 0.02),
        'cm_dw_w': nrm((N_ODD, CONV_K, D), CONV_K ** -0.5),
        'cm_dw_b': nrm((N_ODD, D), 0.02),
        'cm_ln_g': gain((N_ODD, D)),
        'cm_ln_b': nrm((N_ODD, D), 0.02),
        'cm_w_out': nrm((N_ODD, D, D), D ** -0.5),
        'cm_b_out': nrm((N_ODD, D), 0.02),
        'router_w': nrm((DEPTH, D, N_EXPERTS), D ** -0.5),
        'router_b': nrm((DEPTH, N_EXPERTS), 0.01),
        'exp_w1': nrm((DEPTH, N_EXPERTS, D, EXPERT_DIM), D ** -0.5),
        'exp_w3': nrm((DEPTH, N_EXPERTS, D, EXPERT_DIM), D ** -0.5),
        'exp_w2': nrm((DEPTH, N_EXPERTS, EXPERT_DIM, D), EXPERT_DIM ** -0.5),
        'shared_w1': nrm((DEPTH, D, SHARED_DIM), D ** -0.5),
        'shared_w3': nrm((DEPTH, D, SHARED_DIM), D ** -0.5),
        'shared_w2': nrm((DEPTH, SHARED_DIM, D), SHARED_DIM ** -0.5),
    }


def reference(x, c, ctx, c_ctx, mod_w, mod_b, norm_mix_g, norm_ffn_g, final_norm_g,
              ab_w_in, ab_w_out, lru_conv_w, lru_conv_b, lru_wr, lru_br, lru_wi, lru_bi, lru_lambda, attn_sink,
              cm_w_in, cm_b_in, cm_dw_w, cm_dw_b, cm_ln_g, cm_ln_b, cm_w_out, cm_b_out,
              router_w, router_b, exp_w1, exp_w3, exp_w2, shared_w1, shared_w3, shared_w2):
    bsz, n, d = x.shape
    n_ctx = ctx.shape[1]
    rope = _axial_rope_tables(n)
    last_even = ((DEPTH - 1) // 2) * 2
    sc = jax.nn.silu(c)
    scc = jax.nn.silu(c_ctx)
    xc = ctx
    for l in range(DEPTH):
        even = l % 2 == 0
        ctx_live = l < last_even
        mod = (sc @ mod_w[l] + mod_b[l]).reshape(bsz, N_MOD, 1, d)
        h = _modulate(_rmsnorm(x, norm_mix_g[l]), mod[:, 0], mod[:, 1])
        if even or ctx_live:
            modc = (scc @ mod_w[l] + mod_b[l]).reshape(N_MOD, d)
            hc = _modulate(_rmsnorm(xc, norm_mix_g[l]), modc[0], modc[1])
        if even:
            e = l // 2
            y, yc = _mixer_rglru_swa(h, hc, ab_w_in[e], ab_w_out[e], lru_conv_w[e], lru_conv_b[e],
                                     lru_wr[e], lru_br[e], lru_wi[e], lru_bi[e], lru_lambda[e],
                                     attn_sink[e], rope, ctx_live)
        else:
            o = l // 2
            cm = (cm_w_in[o], cm_b_in[o], cm_dw_w[o], cm_dw_b[o], cm_ln_g[o], cm_ln_b[o], cm_w_out[o], cm_b_out[o])
            y = _conformer_conv(h, *cm)
            yc = _conformer_conv(hc, *cm) if ctx_live else None
        x = x + mod[:, 2] * y
        h2 = _modulate(_rmsnorm(x, norm_ffn_g[l]), mod[:, 3], mod[:, 4])
        moe_w = (router_w[l], router_b[l], exp_w1[l], exp_w3[l], exp_w2[l], shared_w1[l], shared_w3[l], shared_w2[l])
        if ctx_live:
            xc = xc + modc[2] * yc
            h2c = _modulate(_rmsnorm(xc, norm_ffn_g[l]), modc[3], modc[4])
            tok = jnp.concatenate([h2.reshape(bsz * n, d), h2c.reshape(bsz * n_ctx, d)], axis=0)
            f = _moe(tok, *moe_w)
            x = x + mod[:, 5] * f[:bsz * n].reshape(bsz, n, d)
            xc = xc + modc[5] * f[bsz * n:].reshape(bsz, n_ctx, d)
        else:
            x = x + mod[:, 5] * _moe(h2.reshape(bsz * n, d), *moe_w).reshape(bsz, n, d)
    return _rmsnorm(x, final_norm_g)
```

```cpp
#include <hip/hip_runtime.h>
#include <cstdio>
#include <cstdint>

#define GAS __attribute__((address_space(1)))
#define LAS __attribute__((address_space(3)))
typedef unsigned short bf16_t;
typedef short bf16x8 __attribute__((ext_vector_type(8)));
typedef short s16x4 __attribute__((ext_vector_type(4)));
typedef float f32x2 __attribute__((ext_vector_type(2)));
typedef float f32x4 __attribute__((ext_vector_type(4)));
typedef float f32x16 __attribute__((ext_vector_type(16)));
typedef unsigned u32x2 __attribute__((ext_vector_type(2)));
typedef unsigned u32x4 __attribute__((ext_vector_type(4)));
typedef int i32x4 __attribute__((ext_vector_type(4)));
typedef int i32x8 __attribute__((ext_vector_type(8)));

constexpr int DM = 1024, NB_ = 16, SEQ = 2048, CTX = 256;
constexpr int T = NB_ * SEQ;
constexpr int TC = NB_ * CTX;
constexpr int MROWS = T + TC;
constexpr int NEXP = 256, NE1 = 257;
constexpr int MAXBLK = 1280 + 128;
constexpr int MAXSLOT = MAXBLK * 256;
constexpr float EPS = 1e-6f;
constexpr float LOG2E = 1.4426950408889634f;

constexpr size_t MiB = 1u << 20;
constexpr size_t WS_CTL = 0, CTL_ZERO_BYTES = 1 * MiB;
constexpr size_t WS_MOD = 1 * MiB;
constexpr size_t WS_ROPE = 2 * MiB;
constexpr size_t WS_GW = 2 * MiB + 65536;
constexpr size_t WS_AG = 3 * MiB;
constexpr size_t WS_CARRY = 8 * MiB;
constexpr size_t WS_SSQ = 10 * MiB;
constexpr size_t WS_TOK_E = 12 * MiB, WS_TOK_R = 13 * MiB, WS_TOK_W = 14 * MiB, WS_TOK_SLOT = 15 * MiB;
constexpr size_t WS_SLOT_TOK = 16 * MiB, WS_SLOT_GATE = 18 * MiB;
constexpr size_t WS_WIN = 20 * MiB, WS_WOUT = 24 * MiB, WS_CIN = 26 * MiB, WS_COUT = 30 * MiB, WS_RT = 32 * MiB;
constexpr size_t WS_E13 = 34 * MiB;
constexpr size_t WS_SB13 = 300 * MiB;
constexpr size_t WS_SA = 302 * MiB;
constexpr size_t WS_SLOT_SA = 303 * MiB;
constexpr size_t WS_SAH = 305 * MiB;
constexpr size_t WS_SBW = 306 * MiB;
constexpr size_t WS_E2 = 548 * MiB;
constexpr size_t WS_X = 806 * MiB;
constexpr size_t WS_H = 934 * MiB;
constexpr size_t WS_HID = 1006 * MiB;
constexpr size_t WS_Y = 1182 * MiB;
constexpr size_t WS_U = WS_Y, WS_G = WS_Y + 36 * MiB, WS_Q = WS_Y + 72 * MiB, WS_K = WS_Y + 108 * MiB, WS_VT = WS_Y + 117 * MiB, WS_VTC = WS_Y + 125 * MiB, WS_Y1 = WS_Y + 126 * MiB;
constexpr size_t WS_GL = WS_Y, WS_ZC = WS_Y + 64 * MiB;
constexpr size_t WS_END = 1886 * MiB;
static_assert(WS_E13 + (size_t)2 * NE1 * 512 * 1024 <= WS_SB13 && WS_SLOT_SA + (size_t)MAXSLOT * 4 <= WS_SAH && WS_SBW + 4096 * 4 <= WS_E2 && WS_E2 + (size_t)2 * NE1 * 1024 * 256 * 2 <= WS_X, "ws map");
static_assert(WS_H + (size_t)MROWS * 1024 * 2 <= WS_HID && WS_HID + (size_t)MAXSLOT * 256 * 2 <= WS_Y && WS_Y + (size_t)MAXSLOT * 1024 * 2 <= WS_END, "ws map");
constexpr int CW_BAR = 4096;
constexpr int CW_NBR = 16384;
constexpr int CW_CNT = 32768;

constexpr int LDS_IDX_OFF = 131072;
constexpr int LDS_SAL_OFF = LDS_IDX_OFF + 5632;
constexpr int LDS_SBL_OFF = LDS_SAL_OFF + 11264;
constexpr int LDS_BLKE_OFF = LDS_SBL_OFF + 11264;
constexpr int LDS_PB_OFF = LDS_BLKE_OFF + 3072;
constexpr int LDS_MISC_OFF = LDS_PB_OFF + 1280;
constexpr int LDS_BYTES = LDS_MISC_OFF + 256;
static_assert(LDS_BYTES <= 160 * 1024 && LDS_BYTES > 80 * 1024, "one workgroup per CU");

__device__ __forceinline__ unsigned cvt_pk_bf16(float lo, float hi) { unsigned r; asm volatile("v_cvt_pk_bf16_f32 %0, %1, %2" : "=v"(r) : "v"(lo), "v"(hi)); return r; }
__device__ __forceinline__ float bf_lo(unsigned u) { return __builtin_bit_cast(float, u << 16); }
__device__ __forceinline__ float bf_hi(unsigned u) { return __builtin_bit_cast(float, u & 0xffff0000u); }
__device__ __forceinline__ float sigm(float x) { return __builtin_amdgcn_rcpf(1.f + __expf(-x)); }
template <int CTRL, int RMASK, bool BC> __device__ __forceinline__ float dppf(float old, float src) {
    return __builtin_bit_cast(float, __builtin_amdgcn_update_dpp(__builtin_bit_cast(int, old), __builtin_bit_cast(int, src), CTRL, RMASK, 0xF, BC)); }
template <int CTRL, int RMASK, bool BC> __device__ __forceinline__ int dppi(int old, int src) { return __builtin_amdgcn_update_dpp(old, src, CTRL, RMASK, 0xF, BC); }
#define DPP_XOR1 0xB1
#define DPP_XOR2 0x4E
#define DPP_ROR4 0x124
#define DPP_ROR8 0x128
#define DPP_HMIRROR 0x141
#define DPP_BC15 0x142
#define DPP_BC31 0x143
__device__ __forceinline__ float rdlane_f(float v, int l) { return __builtin_bit_cast(float, __builtin_amdgcn_readlane(__builtin_bit_cast(int, v), l)); }
__device__ __forceinline__ float wave_sum(float v) {
    v += dppf<DPP_XOR1, 0xF, true>(0.f, v); v += dppf<DPP_XOR2, 0xF, true>(0.f, v); v += dppf<DPP_ROR4, 0xF, true>(0.f, v); v += dppf<DPP_ROR8, 0xF, true>(0.f, v);
    v += dppf<DPP_BC15, 0xA, false>(0.f, v); v += dppf<DPP_BC31, 0xC, false>(0.f, v);
    return rdlane_f(v, 63);
}
__device__ __forceinline__ float wave_max(float v) {
    v = fmaxf(v, dppf<DPP_XOR1, 0xF, true>(0.f, v)); v = fmaxf(v, dppf<DPP_XOR2, 0xF, true>(0.f, v)); v = fmaxf(v, dppf<DPP_ROR4, 0xF, true>(0.f, v)); v = fmaxf(v, dppf<DPP_ROR8, 0xF, true>(0.f, v));
    v = fmaxf(v, dppf<DPP_BC15, 0xA, false>(v, v)); v = fmaxf(v, dppf<DPP_BC31, 0xC, false>(v, v));
    return rdlane_f(v, 63);
}
__device__ __forceinline__ u32x2 pack8_fp8(const f32x4 a, const f32x4 b) { int w0 = 0, w1 = 0;
    w0 = __builtin_amdgcn_cvt_pk_fp8_f32(a[0], a[1], w0, false); w0 = __builtin_amdgcn_cvt_pk_fp8_f32(a[2], a[3], w0, true);
    w1 = __builtin_amdgcn_cvt_pk_fp8_f32(b[0], b[1], w1, false); w1 = __builtin_amdgcn_cvt_pk_fp8_f32(b[2], b[3], w1, true); return (u32x2){(unsigned)w0, (unsigned)w1}; }
#define BAR_LDS() asm volatile("s_waitcnt lgkmcnt(0)\n\ts_barrier" ::: "memory")
#define LDS_WAIT() asm volatile("s_waitcnt lgkmcnt(0)" ::: "memory")

#define XB_TMO      128
#define XB_XCNT(j)  (256  + 64 * (j))
#define XB_XSUB(j)  (1280 + 64 * (j))
#define XB_XGEN(j)  (2304 + 64 * (j))
#define XB_TOP      3328
#define XB_TOPGEN   3392
#define XCD_BAR_WORDS 3456
#define XB_SPIN_CAP (1u << 18)
__device__ __forceinline__ unsigned xb_ld(unsigned* p)              { return __hip_atomic_load(p, __ATOMIC_RELAXED, __HIP_MEMORY_SCOPE_AGENT); }
__device__ __forceinline__ unsigned xb_add(unsigned* p, unsigned v) { return __hip_atomic_fetch_add(p, v, __ATOMIC_RELAXED, __HIP_MEMORY_SCOPE_AGENT); }
__device__ __forceinline__ unsigned xb_xcc_id() { return (unsigned)__builtin_amdgcn_s_getreg((3 << 11) | 20) & 0xFu; }
#define XB_SPIN(cond, bar) do { unsigned _sp = 0; while (cond) { __builtin_amdgcn_s_sleep(1); \
    if ((++_sp & 255u) == 0u) { if (xb_ld(&(bar)[XB_TMO])) break; if (_sp > XB_SPIN_CAP) { atomicAdd(&(bar)[XB_TMO], 1u); break; } } } } while (0)
struct XcdBarrier { unsigned* bar; unsigned x; volatile LAS unsigned* st; };
__device__ __forceinline__ XcdBarrier xcd_barrier_post(unsigned* bar, volatile LAS unsigned* st) {
    XcdBarrier b; b.bar = bar; b.x = xb_xcc_id(); b.st = st;
    if (threadIdx.x == 0) (void)xb_add(&bar[XB_XCNT(b.x)], 1u);
    return b;
}
__device__ __forceinline__ void xcd_barrier_complete(unsigned* bar, unsigned x, unsigned& nloc, unsigned& nx) {
    const unsigned G = gridDim.x * gridDim.y * gridDim.z;
    unsigned sum, cnt, mine, sp = 0u;
    for (;;) {
        sum = 0u; cnt = 0u; mine = 0u;
#pragma unroll
        for (unsigned j = 0; j < 16; ++j) { const unsigned c = xb_ld(&bar[XB_XCNT(j)]); sum += c; cnt += (c > 0u) ? 1u : 0u; mine = (j == x) ? c : mine; }
        if (sum == G) break;
        __builtin_amdgcn_s_sleep(1);
        if ((++sp & 255u) == 0u) { if (xb_ld(&bar[XB_TMO])) break; if (sp > XB_SPIN_CAP) { atomicAdd(&bar[XB_TMO], 1u); break; } }
    }
    nloc = mine > 0u ? mine : 1u; nx = cnt > 0u ? cnt : 1u;
}
__device__ __forceinline__ void xcd_barrier(const XcdBarrier& b) {
    asm volatile("s_waitcnt vmcnt(0)" ::: "memory");
    __syncthreads();
    if (threadIdx.x == 0) {
        unsigned* bar = b.bar;
        __builtin_amdgcn_s_waitcnt(0);
        unsigned nloc = b.st[0], nx = b.st[1];
        if (nloc == 0u) { xcd_barrier_complete(bar, b.x, nloc, nx); b.st[0] = nloc; b.st[1] = nx; }
        const unsigned old = xb_add(&bar[XB_XSUB(b.x)], 1u);
        const unsigned gen = old / nloc;
        if (old + 1u == (gen + 1u) * nloc) {
            __builtin_amdgcn_fence(__ATOMIC_RELEASE, "agent");
            asm volatile("s_waitcnt vmcnt(0)" ::: "memory");
            const unsigned og = xb_add(&bar[XB_TOP], 1u);
            const unsigned tg = og / nx;
            if (og + 1u == (tg + 1u) * nx) xb_add(&bar[XB_TOPGEN], 1u);
            else XB_SPIN(xb_ld(&bar[XB_TOPGEN]) == tg, bar);
            __builtin_amdgcn_fence(__ATOMIC_ACQUIRE, "agent");
            xb_add(&bar[XB_XGEN(b.x)], 1u);
            asm volatile("s_waitcnt vmcnt(0)" ::: "memory");
        } else {
            XB_SPIN(xb_ld(&bar[XB_XGEN(b.x)]) == gen, bar);
            __builtin_amdgcn_fence(__ATOMIC_ACQUIRE, "agent");
            asm volatile("s_waitcnt vmcnt(0)" ::: "memory");
        }
    }
    __syncthreads();
}

namespace pg8 {
constexpr int BM = 256, BK = 64, HALF = 128, HTB = HALF * BK * 2, NXCD = 8, WGM = 8;
__host__ __device__ __forceinline__ int lds_byte(int r, int c) { const int st = (r >> 4) * 2 + (c >> 5), rr = r & 15, cc = c & 31, ob = rr * 64 + cc * 2; return st * 1024 + (ob ^ (((ob >> 9) & 1) << 5)); }
__host__ __device__ __forceinline__ void stage_rc(int b, int& R, int& C) { const int st = b / 1024, sb = b % 1024, swz = sb ^ (((sb >> 9) & 1) << 5); R = (st >> 1) * 16 + swz / 64; C = (st & 1) * 32 + (swz % 64) / 2; }
__host__ __device__ __forceinline__ int perm32(int rho) { const int n = rho >> 4, i = rho & 15; return 8 * (i >> 2) + 4 * n + (i & 3); }

struct Unit { int pm, pn, lrb, ui; const char* A; const char* B; };

struct DenseOrder {
    int nM, nN, nwg, G, c; const char* A; const char* Bt; size_t tstep;
    __device__ void init(const void* A_, const void* Bt_, int M, int N, int K, int G_, int c_) { nM = M / BM; nN = N / BM; nwg = nM * nN; G = G_; c = c_; A = (const char*)A_; Bt = (const char*)Bt_; tstep = (size_t)BM * K * 2; }
    __device__ bool next(int i, Unit& u) const {
        const long L = (long)i * G + c; if (L >= nwg) return false;
        int wgid = (int)L; { const int q = nwg / NXCD, r = nwg % NXCD, xcd = wgid % NXCD, off = wgid / NXCD; wgid = (xcd < r ? xcd * (q + 1) : r * (q + 1) + (xcd - r) * q) + off; }
        const int nig = WGM * nN, gid = wgid / nig, fm = gid * WGM, gsz = (nM - fm) < WGM ? (nM - fm) : WGM;
        u.pm = fm + ((wgid % nig) % gsz); u.pn = (wgid % nig) / gsz; u.lrb = 0; u.ui = i; u.A = A + (size_t)u.pm * tstep; u.B = Bt + (size_t)u.pn * tstep; return true;
    }
    __device__ const LAS unsigned short* rows(int) const { return nullptr; }
};
struct MoeOrder {
    int nunits, G, c, shift; const char* A; const char* Bt; size_t estride, btstep, atstep; const LAS unsigned short* blk_e; const LAS unsigned short* idx; bool gather;
    __device__ bool next(int i, Unit& u) const {
        const int L = i * G + c; if (L >= nunits) return false;
        const int rb = L >> shift, pn = L & ((1 << shift) - 1);
        const int e = __builtin_amdgcn_readfirstlane((int)blk_e[rb]);
        u.pm = rb; u.pn = pn; u.lrb = i; u.ui = i; u.A = gather ? A : A + (size_t)rb * atstep; u.B = Bt + (size_t)e * estride + (size_t)pn * btstep; return true;
    }
    __device__ const LAS unsigned short* rows(int i) const { return idx + i * 256; }
};

template <class Epi, class Sched, bool GATHER>
__device__ __forceinline__ void gemm_phase(LAS unsigned char* lds, const int K, const Sched& S, const Epi& E) {
    const int tid = threadIdx.x, wid = __builtin_amdgcn_readfirstlane(tid >> 6), lane = tid & 63, wr = wid >> 2, wc = wid & 3, fr = lane & 15, fq = lane >> 4;
    const int nt = K / BK;
    int RA[2], CA[2]; unsigned voffB[2];
#pragma unroll
    for (int i = 0; i < 2; ++i) { int R, C; stage_rc(tid * 16 + i * 8192, R, C); const int Rb = Epi::PERM ? ((R & ~31) + perm32(R & 31)) : R;
        RA[i] = R; CA[i] = C; voffB[i] = (unsigned)(Rb * K + C) * 2u; }
    unsigned vA0[2], vA1[2];
    const size_t kstep = (size_t)(BK * 2);
    const size_t hstep = (size_t)HALF * K * 2;
    const unsigned ldsw = (unsigned)wid * 1024u;
    const int aoff = lds_byte(wr * 64 + fr, fq * 8), boff = lds_byte(wc * 32 + fr, fq * 8);
#define PG8_SA(b, h) (((b) * 2 + (h)) * HTB)
#define PG8_SB(b, h) ((4 + (b) * 2 + (h)) * HTB)
#define PG8_STAGE(bufoff, gbase, voff) do { _Pragma("unroll") for (int _i = 0; _i < 2; ++_i) \
        __builtin_amdgcn_global_load_lds((const unsigned*)((const char*)(gbase) + (voff)[_i]), (LAS unsigned*)(lds + (bufoff) + ldsw + _i * 8192), 16, 0, 0); } while (0)
#define PG8_CAT8(p0_, p1_) __builtin_shufflevector(*(const LAS i32x4*)(p0_), *(const LAS i32x4*)(p1_), 0, 1, 2, 3, 4, 5, 6, 7)
#define PG8_LDA(dst, b, h) do { if constexpr (Epi::F8) { _Pragma("unroll") for (int m = 0; m < 4; ++m) dst##8[m] = PG8_CAT8(lds + PG8_SA(b, h) + aoff + m * 2048, lds + PG8_SA(b, h) + aoff + m * 2048 + 1024); } \
        else { _Pragma("unroll") for (int m = 0; m < 4; ++m) _Pragma("unroll") for (int k = 0; k < 2; ++k) dst[m][k] = *(const LAS bf16x8*)(lds + PG8_SA(b, h) + aoff + m * 2048 + k * 1024); } } while (0)
#define PG8_LDB(dst, b, h) do { if constexpr (Epi::F8) { _Pragma("unroll") for (int n = 0; n < 2; ++n) dst##8[n] = PG8_CAT8(lds + PG8_SB(b, h) + boff + n * 2048, lds + PG8_SB(b, h) + boff + n * 2048 + 1024); } \
        else { _Pragma("unroll") for (int n = 0; n < 2; ++n) _Pragma("unroll") for (int k = 0; k < 2; ++k) dst[n][k] = *(const LAS bf16x8*)(lds + PG8_SB(b, h) + boff + n * 2048 + k * 1024); } } while (0)
#define PG8_MMA(ai, bj, At, Bt) do { __builtin_amdgcn_s_setprio(1); \
        if constexpr (Epi::F8) { _Pragma("unroll") for (int m = 0; m < 4; ++m) _Pragma("unroll") for (int n = 0; n < 2; ++n) \
            asm volatile("v_mfma_scale_f32_16x16x128_f8f6f4 %0, %1, %2, %0, %3, %4 op_sel_hi:[0,0,0]" : "+v"(acc[ai][bj][m][n]) : "v"(Bt##8[n]), "v"(At##8[m]), "v"(sclw), "v"(scla)); } \
        else { _Pragma("unroll") for (int m = 0; m < 4; ++m) _Pragma("unroll") for (int n = 0; n < 2; ++n) _Pragma("unroll") for (int k = 0; k < 2; ++k) \
        { if constexpr (Epi::I8) acc[ai][bj][m][n] = __builtin_bit_cast(f32x4, __builtin_amdgcn_mfma_i32_16x16x64_i8(__builtin_bit_cast(i32x4, Bt[n][k]), __builtin_bit_cast(i32x4, At[m][k]), __builtin_bit_cast(i32x4, acc[ai][bj][m][n]), 0, 0, 0)); \
          else acc[ai][bj][m][n] = __builtin_amdgcn_mfma_f32_16x16x32_bf16(Bt[n][k], At[m][k], acc[ai][bj][m][n], 0, 0, 0); } } __builtin_amdgcn_s_setprio(0); } while (0)
#define PG8_WAIT_V(n) asm volatile("s_waitcnt vmcnt(" #n ")" ::: "memory")
#define PG8_WAIT_L(n) asm volatile("s_waitcnt lgkmcnt(" #n ")" ::: "memory")
#define PG8_BAR __builtin_amdgcn_s_barrier()
#define PG8_SCHED __builtin_amdgcn_sched_barrier(0)
#define PG8_SETA(v0, v1, ui_) do { if constexpr (GATHER) { const LAS unsigned short* _rw = S.rows(ui_); _Pragma("unroll") for (int _i = 0; _i < 2; ++_i) { \
            v0[_i] = (unsigned)((int)_rw[RA[_i]] * K + CA[_i]) * 2u; v1[_i] = (unsigned)((int)_rw[HALF + RA[_i]] * K + CA[_i]) * 2u; } } \
        else { _Pragma("unroll") for (int _i = 0; _i < 2; ++_i) { v0[_i] = (unsigned)(RA[_i] * K + CA[_i]) * 2u; v1[_i] = v0[_i]; } } } while (0)
#define PG8_A1(p) (GATHER ? (p) : (p) + hstep)
    Unit cur, nxt; int ui = 0;
    if (!S.next(0, cur)) return;
    f32x4 acc[2][2][4][2];
#pragma unroll
    for (int a = 0; a < 2; ++a)
#pragma unroll
        for (int b = 0; b < 2; ++b)
#pragma unroll
            for (int m = 0; m < 4; ++m)
#pragma unroll
                for (int n = 0; n < 2; ++n) acc[a][b][m][n] = (f32x4){0.f, 0.f, 0.f, 0.f};
    bf16x8 At[4][2], B0[2][2], B1[2][2];
    i32x8 At8[4], B08[2], B18[2];
    int sclw = 0x7b7b7b7b, scla = 0x7f7f7f7f;
    asm volatile("" : "+v"(sclw), "+v"(scla));
    const char* cA = cur.A; const char* cB = cur.B;
    PG8_SETA(vA0, vA1, 0);
    PG8_STAGE(PG8_SB(0, 0), cB, voffB); PG8_STAGE(PG8_SB(0, 1), cB + hstep, voffB); PG8_STAGE(PG8_SA(0, 0), cA, vA0); PG8_STAGE(PG8_SA(0, 1), PG8_A1(cA), vA1);
    if (wr == 1) PG8_BAR;
    PG8_WAIT_V(2); PG8_BAR;
    PG8_STAGE(PG8_SB(1, 0), cB + kstep, voffB); PG8_STAGE(PG8_SA(1, 0), cA + kstep, vA0); PG8_STAGE(PG8_SB(1, 1), cB + hstep + kstep, voffB);
    PG8_WAIT_V(6); PG8_BAR;
    for (;;) {
        const bool has_next = S.next(ui + 1, nxt);
        const char* nA = has_next ? nxt.A : cA; const char* nB = has_next ? nxt.B : cB;
#pragma unroll 1
        for (int t = 0; t < nt; t += 2) {
            const bool last = (t == nt - 2);
            const char* a1 = cA + (size_t)(t + 1) * kstep;
            const char* a2 = last ? nA : cA + (size_t)(t + 2) * kstep; const char* b2 = last ? nB : cB + (size_t)(t + 2) * kstep;
            const char* a3 = a2 + kstep; const char* b3 = b2 + kstep;
            PG8_LDB(B0, 0, 0); PG8_LDB(B1, 0, 1); PG8_SCHED; PG8_LDA(At, 0, 0); PG8_STAGE(PG8_SA(1, 1), PG8_A1(a1), vA1);
            if constexpr (GATHER) { if (last && has_next) PG8_SETA(vA0, vA1, ui + 1); }
            PG8_WAIT_V(8); PG8_WAIT_L(0); PG8_BAR; PG8_MMA(0, 0, At, B0); PG8_MMA(0, 1, At, B1); PG8_BAR; PG8_SCHED;
            PG8_LDA(At, 0, 1); PG8_STAGE(PG8_SB(0, 0), b2, voffB); PG8_STAGE(PG8_SB(0, 1), b2 + hstep, voffB); PG8_STAGE(PG8_SA(0, 0), a2, vA0);
            PG8_WAIT_V(8); PG8_WAIT_L(0); PG8_BAR; PG8_MMA(1, 0, At, B0); PG8_MMA(1, 1, At, B1); PG8_BAR; PG8_SCHED;
            PG8_LDB(B0, 1, 0); PG8_LDB(B1, 1, 1); PG8_SCHED; PG8_LDA(At, 1, 0); PG8_STAGE(PG8_SA(0, 1), PG8_A1(a2), vA1);
            PG8_WAIT_V(8); PG8_WAIT_L(0); PG8_BAR; PG8_MMA(0, 0, At, B0); PG8_MMA(0, 1, At, B1); PG8_BAR; PG8_SCHED;
            PG8_LDA(At, 1, 1); PG8_STAGE(PG8_SB(1, 0), b3, voffB); PG8_STAGE(PG8_SB(1, 1), b3 + hstep, voffB); PG8_STAGE(PG8_SA(1, 0), a3, vA0);
            PG8_WAIT_V(8); PG8_WAIT_L(0); PG8_BAR; PG8_MMA(1, 0, At, B0); PG8_MMA(1, 1, At, B1); PG8_BAR; PG8_SCHED;
        }
        if (wr == 0) PG8_BAR;
        if constexpr (Epi::F8) asm volatile("s_nop 15\n\ts_nop 15" ::: "memory");
        E(acc, cur, wr, wc, fr, fq);
        if (!has_next) break;
#pragma unroll
        for (int a = 0; a < 2; ++a)
#pragma unroll
            for (int b = 0; b < 2; ++b)
#pragma unroll
                for (int m = 0; m < 4; ++m)
#pragma unroll
                    for (int n = 0; n < 2; ++n) acc[a][b][m][n] = (f32x4){0.f, 0.f, 0.f, 0.f};
        cur = nxt; cA = nA; cB = nB; ++ui;
        if (wr == 1) PG8_BAR;
    }
    PG8_WAIT_V(0);
    PG8_BAR;
#undef PG8_SA
#undef PG8_SB
#undef PG8_STAGE
#undef PG8_LDA
#undef PG8_CAT8
#undef PG8_LDB
#undef PG8_MMA
#undef PG8_WAIT_V
#undef PG8_WAIT_L
#undef PG8_BAR
#undef PG8_SCHED
#undef PG8_SETA
#undef PG8_A1
}
}

using pg8::Unit;
typedef f32x4 Acc[2][2][4][2];
__device__ __forceinline__ u32x4 pack8(const f32x4 a, const f32x4 b) { u32x4 w; w.x = cvt_pk_bf16(a[0], a[1]); w.y = cvt_pk_bf16(a[2], a[3]); w.z = cvt_pk_bf16(b[0], b[1]); w.w = cvt_pk_bf16(b[2], b[3]); return w; }
#define ST16(base, off, v) (*(u32x4*)((char*)(base) + (unsigned)(off)) = (v))
#define LDF4(base, off) (*(const f32x4*)((const char*)(base) + (unsigned)(off)))

__device__ __forceinline__ f32x4 i8f(const f32x4 a, const float ra, const f32x4 sb) { const i32x4 v = __builtin_bit_cast(i32x4, a); return (f32x4){(float)v[0], (float)v[1], (float)v[2], (float)v[3]} * (sb * ra); }
struct EpiInProj {
    static constexpr bool PERM = true, I8 = true, F8 = false;
    bf16_t *U, *G, *Q, *Kb, *VT, *VTC; const float* rope; const float* sa; const float* sb;
    __device__ __forceinline__ void operator()(const Acc& acc, const Unit& u, int wr, int wc, int fr, int fq) const {
        const int pn = u.pn, rowb = u.pm * 256 + wr * 64 + fr, c8 = wc * 32 + 8 * fq;
        if (pn >= 2 && pn < 6 && u.pm >= T / 256) return;
        const unsigned so = (unsigned)(pn * 256 + c8) * 4u;
        const f32x4 s00 = LDF4(sb, so), s01 = LDF4(sb, so + 16u), s10 = LDF4(sb, so + 512u), s11 = LDF4(sb, so + 528u);
        float rav[2][4];
#pragma unroll
        for (int ai = 0; ai < 2; ++ai)
#pragma unroll
            for (int m = 0; m < 4; ++m) rav[ai][m] = *(const float*)((const char*)sa + (unsigned)(rowb + ai * 128 + m * 16) * 4u);
        if (pn < 4) {
            bf16_t* base = (pn < 2 ? U : G);
            const unsigned o0 = (unsigned)(rowb * 512 + (pn & 1) * 256 + c8) * 2u;
            __builtin_amdgcn_sched_barrier(0);
#pragma unroll
            for (int ai = 0; ai < 2; ++ai)
#pragma unroll
                for (int m = 0; m < 4; ++m) { const float ra = rav[ai][m];
                    ST16(base, o0 + (unsigned)((ai * 128 + m * 16) * 512) * 2u, pack8(i8f(acc[ai][0][m][0], ra, s00), i8f(acc[ai][0][m][1], ra, s01)));
                    ST16(base, o0 + (unsigned)((ai * 128 + m * 16) * 512 + 128) * 2u, pack8(i8f(acc[ai][1][m][0], ra, s10), i8f(acc[ai][1][m][1], ra, s11))); }
        } else if (pn < 6) {
            const float QS = 0.125f * LOG2E;
            const unsigned o0 = (unsigned)(rowb * 512 + (pn - 4) * 256 + c8) * 2u;
#pragma unroll
            for (int ai = 0; ai < 2; ++ai) { f32x4 r0[4], r1[4];
#pragma unroll
                for (int m = 0; m < 4; ++m) { const int row = rowb + ai * 128 + m * 16, sq = row & (SEQ - 1), pos = (wc & 1) ? (sq & 63) : (sq >> 6);
                    const unsigned ro = (unsigned)((pos * 16 + 4 * fq) * 8); r0[m] = LDF4(rope, ro); r1[m] = LDF4(rope, ro + 16u); }
                __builtin_amdgcn_sched_barrier(0);
#pragma unroll
                for (int m = 0; m < 4; ++m) { const float ra = rav[ai][m] * QS;
                    const f32x4 cs = {r0[m][0], r0[m][2], r1[m][0], r1[m][2]}, sn = {r0[m][1], r0[m][3], r1[m][1], r1[m][3]};
#pragma unroll
                    for (int bj = 0; bj < 2; ++bj) { const f32x4 x1 = i8f(acc[ai][bj][m][0], ra, bj ? s10 : s00), x2 = i8f(acc[ai][bj][m][1], ra, bj ? s11 : s01);
                        ST16(Q, o0 + (unsigned)((ai * 128 + m * 16) * 512 + bj * 128) * 2u, pack8(x1 * cs - x2 * sn, x2 * cs + x1 * sn)); } }
                __builtin_amdgcn_sched_barrier(0); }
        } else {
#pragma unroll
            for (int ai = 0; ai < 2; ++ai) { f32x4 r0[4], r1[4];
#pragma unroll
                for (int m = 0; m < 4; ++m) { const int row = rowb + ai * 128 + m * 16, sq = row & (SEQ - 1), pos = (wc & 1) ? (sq & 63) : (sq >> 6);
                    const unsigned ro = (unsigned)((pos * 16 + 4 * fq) * 8); r0[m] = LDF4(rope, ro); r1[m] = LDF4(rope, ro + 16u); }
                __builtin_amdgcn_sched_barrier(0);
#pragma unroll
                for (int m = 0; m < 4; ++m) { const int row = rowb + ai * 128 + m * 16; const float ra = rav[ai][m];
                    f32x4 x1 = i8f(acc[ai][0][m][0], ra, s00), x2 = i8f(acc[ai][0][m][1], ra, s01);
                    if (row < T) { const f32x4 cs = {r0[m][0], r0[m][2], r1[m][0], r1[m][2]}, sn = {r0[m][1], r0[m][3], r1[m][1], r1[m][3]};
                        const f32x4 o1 = x1 * cs - x2 * sn, o2 = x2 * cs + x1 * sn; x1 = o1; x2 = o2; }
                    ST16(Kb, (unsigned)(row * 128 + c8) * 2u, pack8(x1, x2));
                    ST16(VT, (unsigned)(row * 128 + c8) * 2u, pack8(i8f(acc[ai][1][m][0], ra, s10), i8f(acc[ai][1][m][1], ra, s11))); }
                __builtin_amdgcn_sched_barrier(0); }
        }
    }
};
struct EpiResid {
    static constexpr bool PERM = true, I8 = false, F8 = true;
    bf16_t* xs; const float* gate; const float* bias; float* ssq;
    __device__ __forceinline__ void operator()(const Acc& acc, const Unit& u, int wr, int wc, int fr, int fq) const {
        const int rowb = u.pm * 256 + wr * 64 + fr, col0 = u.pn * 256 + wc * 32 + 8 * fq;
        const unsigned go = (unsigned)(((u.pm * 256) >> 11) * 6144 + col0) * 4u;
        f32x4 g[2][2], bb[2][2];
#pragma unroll
        for (int bj = 0; bj < 2; ++bj)
#pragma unroll
            for (int n = 0; n < 2; ++n) { g[bj][n] = LDF4(gate, go + (unsigned)(bj * 128 + 4 * n) * 4u); bb[bj][n] = bias ? LDF4(bias, (unsigned)(col0 + bj * 128 + 4 * n) * 4u) : (f32x4){0.f, 0.f, 0.f, 0.f}; }
#pragma unroll
        for (int ai = 0; ai < 2; ++ai) { u32x4 xw[4][2];
#pragma unroll
            for (int m = 0; m < 4; ++m)
#pragma unroll
                for (int bj = 0; bj < 2; ++bj) xw[m][bj] = *(const u32x4*)((const char*)xs + ((unsigned)((rowb + ai * 128 + m * 16) * DM + col0) + (unsigned)(bj * 128)) * 2u);
            __builtin_amdgcn_sched_barrier(0);
#pragma unroll
            for (int m = 0; m < 4; ++m) { const int row = rowb + ai * 128 + m * 16; const unsigned xo = (unsigned)(row * DM + col0);
                float ss = 0.f;
#pragma unroll
                for (int bj = 0; bj < 2; ++bj) { const u32x4 w = xw[m][bj];
                    const f32x4 x0 = {bf_lo(w.x), bf_hi(w.x), bf_lo(w.y), bf_hi(w.y)}, x1 = {bf_lo(w.z), bf_hi(w.z), bf_lo(w.w), bf_hi(w.w)};
                    const f32x4 y0 = x0 + g[bj][0] * (acc[ai][bj][m][0] + bb[bj][0]), y1 = x1 + g[bj][1] * (acc[ai][bj][m][1] + bb[bj][1]);
                    ST16(xs, (xo + (unsigned)(bj * 128)) * 2u, pack8(y0, y1));
                    ss += ((y0[0] * y0[0] + y0[1] * y0[1]) + (y0[2] * y0[2] + y0[3] * y0[3])) + ((y1[0] * y1[0] + y1[1] * y1[1]) + (y1[2] * y1[2] + y1[3] * y1[3])); }
                ss += __shfl_xor(ss, 16); ss += __shfl_xor(ss, 32);
                if (fq == 0) *(float*)((char*)ssq + (unsigned)(row * 16 + u.pn * 4 + wc) * 4u) = ss; }
            __builtin_amdgcn_sched_barrier(0); }
    }
};
struct EpiMoe1 {
    static constexpr bool PERM = true, I8 = true, F8 = false;
    unsigned char* HID; const LAS float* sal; const LAS float* sbl;
    __device__ __forceinline__ void operator()(const Acc& acc, const Unit& u, int wr, int wc, int fr, int fq) const {
        const int rowb = u.pm * 256 + wr * 64 + fr;
        const unsigned o0 = (unsigned)(rowb * 256 + u.pn * 128 + wc * 32 + 16 * (fq & 1)) + ((fq >> 1) ? 16u * 256u : 0u);
        const LAS float* sp = sbl + u.ui * 256 + wc * 32 + 8 * fq;
        const f32x4 s10 = *(const LAS f32x4*)sp, s11 = *(const LAS f32x4*)(sp + 4), s30 = *(const LAS f32x4*)(sp + 128), s31 = *(const LAS f32x4*)(sp + 132);
        const LAS float* rp = sal + u.lrb * 256 + wr * 64 + fr;
#pragma unroll
        for (int ai = 0; ai < 2; ++ai)
#pragma unroll
            for (int mp = 0; mp < 2; ++mp) { const float ra0 = rp[ai * 128 + mp * 32], ra1 = rp[ai * 128 + mp * 32 + 16];
                if (__builtin_amdgcn_ballot_w64(ra0 != 0.f || ra1 != 0.f) == 0) continue;
                u32x2 P[2];
#pragma unroll
                for (int h = 0; h < 2; ++h) { const int m = 2 * mp + h; const float ra = h ? ra1 : ra0; f32x4 h0, h1;
                    const i32x4 a0i = __builtin_bit_cast(i32x4, acc[ai][0][m][0]), a1i = __builtin_bit_cast(i32x4, acc[ai][0][m][1]), b0i = __builtin_bit_cast(i32x4, acc[ai][1][m][0]), b1i = __builtin_bit_cast(i32x4, acc[ai][1][m][1]);
#pragma unroll
                    for (int j = 0; j < 4; ++j) { const float a0 = (float)a0i[j] * (ra * s10[j]), a1 = (float)a1i[j] * (ra * s11[j]), b0 = (float)b0i[j] * (ra * s30[j]), b1 = (float)b1i[j] * (ra * s31[j]);
                        h0[j] = a0 * sigm(a0) * b0; h1[j] = a1 * sigm(a1) * b1; }
                    P[h] = pack8_fp8(h0, h1); }
                const u32x2 sx = __builtin_amdgcn_permlane32_swap(P[0].x, P[1].x, false, false), sy = __builtin_amdgcn_permlane32_swap(P[0].y, P[1].y, false, false);
                *(u32x4*)((char*)HID + (o0 + (unsigned)((ai * 128 + mp * 32) * 256))) = (u32x4){sx.x, sy.x, sx.y, sy.y}; }
    }
};
struct EpiMoe2 {
    static constexpr bool PERM = true, I8 = false, F8 = true;
    unsigned char* Y; const LAS float* gl;
    __device__ __forceinline__ void operator()(const Acc& acc, const Unit& u, int wr, int wc, int fr, int fq) const {
        const int rowb = u.pm * 256 + wr * 64 + fr; const unsigned o0 = (unsigned)(rowb * DM + u.pn * 256 + wc * 64 + 16 * fq);
        const LAS float* gp = gl + u.lrb * 256 + wr * 64 + fr;
#pragma unroll
        for (int ai = 0; ai < 2; ++ai)
#pragma unroll
            for (int m = 0; m < 4; ++m) { const float g = 16.f * gp[ai * 128 + m * 16];
                if (__builtin_amdgcn_ballot_w64(g != 0.f) == 0) continue;
                const u32x2 lo = pack8_fp8(acc[ai][0][m][0] * g, acc[ai][0][m][1] * g), hi = pack8_fp8(acc[ai][1][m][0] * g, acc[ai][1][m][1] * g);
                *(u32x4*)((char*)Y + (o0 + (unsigned)((ai * 128 + m * 16) * DM))) = (u32x4){lo.x, lo.y, hi.x, hi.y}; }
    }
};
struct EpiGlu {
    static constexpr bool PERM = true, I8 = true, F8 = false;
    bf16_t* GL; const float* bias; const float* sa; const float* sb;
    __device__ __forceinline__ void operator()(const Acc& acc, const Unit& u, int wr, int wc, int fr, int fq) const {
        const int col = u.pn * 128 + wc * 32 + 8 * fq, rowb = u.pm * 256 + wr * 64 + fr; const unsigned o0 = (unsigned)(rowb * DM + col) * 2u, bo = (unsigned)col * 4u;
        const unsigned so = (unsigned)(u.pn * 256 + wc * 32 + 8 * fq) * 4u;
        const f32x4 s00 = LDF4(sb, so), s01 = LDF4(sb, so + 16u), s10 = LDF4(sb, so + 512u), s11 = LDF4(sb, so + 528u);
        const f32x4 bv0 = LDF4(bias, bo), bv1 = LDF4(bias, bo + 16u), bg0 = LDF4(bias, bo + 4096u), bg1 = LDF4(bias, bo + 4112u);
        float rav[2][4];
#pragma unroll
        for (int ai = 0; ai < 2; ++ai)
#pragma unroll
            for (int m = 0; m < 4; ++m) rav[ai][m] = *(const float*)((const char*)sa + (unsigned)(rowb + ai * 128 + m * 16) * 4u);
        __builtin_amdgcn_sched_barrier(0);
#pragma unroll
        for (int ai = 0; ai < 2; ++ai)
#pragma unroll
            for (int m = 0; m < 4; ++m) { f32x4 o0v, o1v; const float ra = rav[ai][m];
                const f32x4 v0 = i8f(acc[ai][0][m][0], ra, s00) + bv0, v1 = i8f(acc[ai][0][m][1], ra, s01) + bv1, g0 = i8f(acc[ai][1][m][0], ra, s10) + bg0, g1 = i8f(acc[ai][1][m][1], ra, s11) + bg1;
#pragma unroll
                for (int j = 0; j < 4; ++j) { o0v[j] = v0[j] * sigm(g0[j]); o1v[j] = v1[j] * sigm(g1[j]); }
                ST16(GL, o0 + (unsigned)((ai * 128 + m * 16) * DM) * 2u, pack8(o0v, o1v)); }
    }
};

struct Args { const float* in[35]; float* out; unsigned char* ws; int ph_lo, ph_hi; };
enum { I_X = 0, I_C, I_CTX, I_CCTX, I_MODW, I_MODB, I_NMIXG, I_NFFNG, I_FING, I_ABWIN, I_ABWOUT, I_LCW, I_LCB, I_LWR, I_LBR, I_LWI, I_LBI, I_LLAM, I_SINK,
       I_CMWIN, I_CMBIN, I_CMDWW, I_CMDWB, I_CMLNG, I_CMLNB, I_CMWOUT, I_CMBOUT, I_RW, I_RB, I_EW1, I_EW3, I_EW2, I_SW1, I_SW3, I_SW2 };

__device__ __forceinline__ int linv32(int nn) { return 8 * ((nn >> 2) & 3) + 4 * (nn >> 4) + (nn & 3); }
__device__ __forceinline__ int t21map(int nn) { return 8 * ((nn >> 4) + 2 * ((nn >> 3) & 1)) + (nn & 7); }
__device__ __forceinline__ void tr_item(const float* W, int K, int N, int k0, int n0, bf16_t* WT, int drow0, bool perm, bool frag, LAS float* scr, int lane) {
    f32x4 v[8];
#pragma unroll
    for (int i = 0; i < 8; ++i) v[i] = *(const f32x4*)(W + (size_t)(k0 + i * 8 + (lane >> 3)) * N + n0 + 4 * (lane & 7));
#pragma unroll
    for (int i = 0; i < 8; ++i) { LAS float* s = scr + (i * 8 + (lane >> 3)) * 33 + 4 * (lane & 7); s[0] = v[i][0]; s[1] = v[i][1]; s[2] = v[i][2]; s[3] = v[i][3]; }
    LDS_WAIT(); asm volatile("" ::: "memory");
    const int c = lane & 7;
#pragma unroll
    for (int j = 0; j < 4; ++j) { const int n = (lane >> 3) + 8 * j; const LAS float* s = scr + (8 * c) * 33 + n;
        u32x4 o; o.x = cvt_pk_bf16(s[0 * 33], s[1 * 33]); o.y = cvt_pk_bf16(s[2 * 33], s[3 * 33]); o.z = cvt_pk_bf16(s[4 * 33], s[5 * 33]); o.w = cvt_pk_bf16(s[6 * 33], s[7 * 33]);
        const int dr = drow0 + (perm ? linv32(n) : n);
        if (frag) *(u32x4*)(WT + (size_t)((((dr >> 5) * 64 + (k0 >> 4) + (c >> 1)) * 64 + (c & 1) * 32 + (dr & 31)) * 8)) = o;
        else *(u32x4*)(WT + (size_t)dr * K + k0 + 8 * c) = o; }
    LDS_WAIT(); asm volatile("" ::: "memory");
}
constexpr int IT_WIN = 16 * 56, IT_SQ = 16 * 32, IT_CIN = 16 * 64, IT_RT = 16 * 8;
constexpr int IT_DENSE = IT_WIN + IT_SQ + IT_CIN + IT_SQ + 2 * IT_RT;
constexpr int IT_EXP = 2 * NE1 * 128;
constexpr int IT_Q = 2 * NE1 * 16;
__device__ __forceinline__ void tr_item_fp8(const float* W, int K, int N, int k0, int n0, unsigned char* WT, LAS float* scr, int lane) {
    f32x4 v[8];
#pragma unroll
    for (int i = 0; i < 8; ++i) v[i] = *(const f32x4*)(W + (size_t)(k0 + i * 8 + (lane >> 3)) * N + n0 + 4 * (lane & 7));
#pragma unroll
    for (int i = 0; i < 8; ++i) { LAS float* s = scr + (i * 8 + (lane >> 3)) * 33 + 4 * (lane & 7); s[0] = v[i][0]; s[1] = v[i][1]; s[2] = v[i][2]; s[3] = v[i][3]; }
    LDS_WAIT(); asm volatile("" ::: "memory");
    const int c = lane & 7;
#pragma unroll
    for (int j = 0; j < 4; ++j) { const int n = (lane >> 3) + 8 * j; const LAS float* s = scr + (8 * c) * 33 + n;
        const f32x4 a = {16.f * s[0 * 33], 16.f * s[1 * 33], 16.f * s[2 * 33], 16.f * s[3 * 33]}, b = {16.f * s[4 * 33], 16.f * s[5 * 33], 16.f * s[6 * 33], 16.f * s[7 * 33]};
        *(u32x2*)(WT + (size_t)(n0 + n) * K + k0 + 8 * c) = pack8_fp8(a, b); }
    LDS_WAIT(); asm volatile("" ::: "memory");
}
struct TrDesc { const float* W; void* dst; int K, N, k0, n0; bool f8; };
__device__ __forceinline__ TrDesc tr_decode(const Args& a, int it) {
    unsigned char* ws = a.ws; TrDesc d; d.f8 = false; int r = it;
    if (r < IT_SQ) { d.W = a.in[I_ABWOUT]; d.K = 1024; d.N = 1024; d.k0 = (r / 32) * 64; d.n0 = (r % 32) * 32; d.dst = ws + WS_WOUT; d.f8 = true; return d; } r -= IT_SQ;
    if (r < IT_SQ) { d.W = a.in[I_CMWOUT]; d.K = 1024; d.N = 1024; d.k0 = (r / 32) * 64; d.n0 = (r % 32) * 32; d.dst = ws + WS_COUT; d.f8 = true; return d; } r -= IT_SQ;
    if (r < 2 * IT_RT) { const int l = r / IT_RT, q = r % IT_RT; d.W = a.in[I_RW] + (size_t)l * 1024 * 256; d.K = 1024; d.N = 256; d.k0 = (q / 8) * 64; d.n0 = (q % 8) * 32; d.dst = (bf16_t*)(ws + WS_RT) + (size_t)l * 256 * 1024; return d; } r -= 2 * IT_RT;
    const int l = r / (NE1 * 128), r2 = r % (NE1 * 128), e = r2 >> 7, qq = r2 & 127;
    d.W = (e < NEXP) ? a.in[I_EW2] + (size_t)(l * NEXP + e) * 256 * 1024 : a.in[I_SW2] + (size_t)l * 256 * 1024;
    d.K = 256; d.N = 1024; d.k0 = (qq >> 5) * 64; d.n0 = (qq & 31) * 32; d.dst = ws + WS_E2 + (size_t)(l * NE1 + e) * 1024 * 256; d.f8 = true; return d;
}
__device__ __forceinline__ u32x4 pack16_fp8(const f32x4 (&v)[16], int jn) { u32x4 o;
#pragma unroll
    for (int d = 0; d < 4; ++d) { int w = 0; w = __builtin_amdgcn_cvt_pk_fp8_f32(16.f * v[4 * d][jn], 16.f * v[4 * d + 1][jn], w, false); w = __builtin_amdgcn_cvt_pk_fp8_f32(16.f * v[4 * d + 2][jn], 16.f * v[4 * d + 3][jn], w, true); o[d] = (unsigned)w; }
    return o; }
__device__ __forceinline__ void p0_convert(const Args& a, LAS unsigned char* lds, int gw, int NGW, int wave, int lane) {
    LAS float* scr = (LAS float*)(lds + wave * 16384);
    for (int it = gw; it < 2 * IT_SQ + 2 * IT_RT; it += NGW) { const TrDesc d = tr_decode(a, it); if (d.f8) tr_item_fp8(d.W, d.K, d.N, d.k0, d.n0, (unsigned char*)d.dst, scr, lane); else tr_item(d.W, d.K, d.N, d.k0, d.n0, (bf16_t*)d.dst, d.n0, false, true, scr, lane); }
    constexpr int NW2 = 2 * NE1 * 64;
    const int g = lane >> 3, q = lane & 7;
#define W2_DECODE(it_) const int l_ = (it_) / (NE1 * 64), r2_ = (it_) % (NE1 * 64), e_ = r2_ >> 6, kp_ = (r2_ >> 5) & 1, nb_ = r2_ & 31; \
        const float* W_ = (e_ < NEXP) ? a.in[I_EW2] + (size_t)(l_ * NEXP + e_) * 256 * 1024 : a.in[I_SW2] + (size_t)l_ * 256 * 1024; \
        unsigned char* D_ = a.ws + WS_E2 + (size_t)(l_ * NE1 + e_) * 1024 * 256; (void)D_;
#define W2_LOAD(buf, it_) do { W2_DECODE(it_); _Pragma("unroll") for (int i = 0; i < 16; ++i) buf[i] = __builtin_nontemporal_load((const f32x4*)(W_ + (size_t)(128 * kp_ + 16 * g + i) * 1024 + nb_ * 32 + 4 * q)); } while (0)
#define W2_STORE(buf, it_) do { W2_DECODE(it_); (void)W_; _Pragma("unroll") for (int jn = 0; jn < 4; ++jn) __builtin_nontemporal_store(pack16_fp8(buf, jn), (u32x4*)(D_ + (size_t)(nb_ * 32 + 4 * q + jn) * 256 + 128 * kp_ + 16 * g)); } while (0)
    f32x4 va[16], vb[16];
    if (gw < NW2) W2_LOAD(va, gw);
    for (int it = gw; it < NW2; it += 2 * NGW) {
        if (it + NGW < NW2) W2_LOAD(vb, it + NGW);
        __builtin_amdgcn_sched_barrier(0);
        W2_STORE(va, it);
        __builtin_amdgcn_sched_barrier(0);
        if (it + NGW < NW2) {
            if (it + 2 * NGW < NW2) W2_LOAD(va, it + 2 * NGW);
            __builtin_amdgcn_sched_barrier(0);
            W2_STORE(vb, it + NGW);
            __builtin_amdgcn_sched_barrier(0);
        }
    }
#undef W2_DECODE
#undef W2_LOAD
#undef W2_STORE
}
__device__ __forceinline__ void p0_quant(const Args& a, LAS unsigned char* lds, int bid, int G, int dry) {
    const int tid = threadIdx.x, w = tid >> 6, lane = tid & 63, g = lane >> 3, q = lane & 7;
    LAS float* pm = (LAS float*)lds;
    constexpr int NIT = IT_Q + 56 + 64;
#define Q_DECODE(it_) const float* W; int ldw, n0, drow0; bool perm = false; const bool t21 = (it_) < IT_Q; signed char* dst; float* sb; \
        if ((it_) < IT_Q) { const int l_ = (it_) / (NE1 * 16), r2_ = (it_) % (NE1 * 16), e_ = r2_ >> 4, which_ = (r2_ >> 3) & 1, nb_ = r2_ & 7; n0 = nb_ * 32; ldw = 256; \
            W = (e_ < NEXP) ? a.in[which_ ? I_EW3 : I_EW1] + (size_t)(l_ * NEXP + e_) * 1024 * 256 : a.in[which_ ? I_SW3 : I_SW1] + (size_t)l_ * 1024 * 256; \
            drow0 = (n0 >> 7) * 256 + (n0 & 127) + (which_ ? 128 : 0); \
            dst = (signed char*)(a.ws + WS_E13) + (size_t)(l_ * NE1 + e_) * 512 * 1024; sb = (float*)(a.ws + WS_SB13) + (size_t)(l_ * NE1 + e_) * 512; } \
        else if ((it_) < IT_Q + 56) { n0 = ((it_) - IT_Q) * 32; ldw = 1792; W = a.in[I_ABWIN]; drow0 = n0; perm = (n0 >= 1024 && n0 < 1664); dst = (signed char*)(a.ws + WS_WIN); sb = (float*)(a.ws + WS_SBW); } \
        else { n0 = ((it_) - IT_Q - 56) * 32; ldw = 2048; W = a.in[I_CMWIN]; const int nn_ = n0 & 1023; drow0 = (nn_ >> 7) * 256 + (nn_ & 127) + (n0 >= 1024 ? 128 : 0); dst = (signed char*)(a.ws + WS_CIN); sb = (float*)(a.ws + WS_SBW) + 1792; }
#define Q_LOAD(buf, it_) do { Q_DECODE(it_); (void)drow0; (void)perm; (void)t21; (void)dst; (void)sb; _Pragma("unroll") for (int i = 0; i < 16; ++i) buf[i] = __builtin_nontemporal_load((const f32x4*)(W + (size_t)(128 * w + 16 * g + i) * ldw + n0 + 4 * q)); } while (0)
#define Q_BODY(buf, it_, par_) do { if (dry == 1) break; Q_DECODE(it_); \
        f32x4 m4 = {0.f, 0.f, 0.f, 0.f}; _Pragma("unroll") for (int i = 0; i < 16; ++i) m4 = __builtin_elementwise_max(m4, __builtin_elementwise_abs(buf[i])); \
        LAS float* pmp = pm + (par_) * 2048; \
        *(LAS f32x4*)(pmp + (w * 8 + g) * 32 + 4 * q) = m4; \
        BAR_LDS();                                                        \
        _Pragma("unroll 8") for (int p = 0; p < 64; ++p) m4 = __builtin_elementwise_max(m4, *(const LAS f32x4*)(pmp + p * 32 + 4 * q)); \
        f32x4 sc4, iv4; _Pragma("unroll") for (int jn = 0; jn < 4; ++jn) { sc4[jn] = (m4[jn] > 0.f) ? m4[jn] * (1.f / 127.f) : 1.f; iv4[jn] = 1.f / sc4[jn]; } \
        if (w == 0 && g == 0) { _Pragma("unroll") for (int jn = 0; jn < 4; ++jn) { const int nn = 4 * q + jn; sb[drow0 + (perm ? linv32(nn) : (t21 ? t21map(nn) : nn))] = sc4[jn]; } } \
        _Pragma("unroll") for (int jn = 0; jn < 4; ++jn) { u32x4 o; \
            _Pragma("unroll") for (int d = 0; d < 4; ++d) { unsigned pk = 0u; \
                _Pragma("unroll") for (int e = 0; e < 4; ++e) { int qi = (int)__builtin_rintf(buf[4 * d + e][jn] * iv4[jn]); qi = min(max(qi, -127), 127); pk |= ((unsigned)qi & 0xffu) << (8 * e); } o[d] = pk; } \
            const int nn = 4 * q + jn; if (dry != 2 || n0 < 0) __builtin_nontemporal_store(o, (u32x4*)(dst + (size_t)(drow0 + (perm ? linv32(nn) : (t21 ? t21map(nn) : nn))) * 1024 + 128 * w + 16 * g)); } } while (0)
    f32x4 va[16], vb[16];
    if (bid < NIT) Q_LOAD(va, bid);
    for (int it = bid; it < NIT; it += 2 * G) {
        if (it + G < NIT) Q_LOAD(vb, it + G);
        __builtin_amdgcn_sched_barrier(0);
        Q_BODY(va, it, 0);
        __builtin_amdgcn_sched_barrier(0);
        if (it + G < NIT) {
            if (it + 2 * G < NIT) Q_LOAD(va, it + 2 * G);
            __builtin_amdgcn_sched_barrier(0);
            Q_BODY(vb, it + G, 1);
            __builtin_amdgcn_sched_barrier(0);
        }
    }
#undef Q_DECODE
#undef Q_LOAD
#undef Q_BODY
}
__device__ __forceinline__ void p0_mod(const Args& a, LAS unsigned char* lds, int tid, int G, int bid) {
    LAS float* sc = (LAS float*)lds;
    LAS float* red = (LAS float*)(lds + 17 * 1024 * 4);
    for (int i = tid; i < 17 * 1024; i += 512) { const int r = i >> 10, k = i & 1023; const float v = (r < 16) ? a.in[I_C][r * 1024 + k] : a.in[I_CCTX][k]; sc[i] = v * sigm(v); }
    __syncthreads();
    float* MOD = (float*)(a.ws + WS_MOD);
    const int cq = tid & 15, kq = tid >> 4, wv = tid >> 6;
    for (int slab = bid; slab < 192; slab += G) {
        const int cg = slab * 64, l = cg / 6144, cc0 = cg % 6144;
        const float* wp = a.in[I_MODW] + (size_t)l * 1024 * 6144 + cc0 + 4 * cq;
        f32x4 acc[17];
#pragma unroll
        for (int r = 0; r < 17; ++r) acc[r] = (f32x4){0.f, 0.f, 0.f, 0.f};
#pragma unroll 8
        for (int k = kq; k < 1024; k += 32) { const f32x4 w = *(const f32x4*)(wp + (size_t)k * 6144);
#pragma unroll
            for (int r = 0; r < 17; ++r) acc[r] += w * sc[r * 1024 + k]; }
#pragma unroll
        for (int r = 0; r < 17; ++r)
#pragma unroll
            for (int j = 0; j < 4; ++j) { float v = acc[r][j]; v += __shfl_xor(v, 16); v += __shfl_xor(v, 32); acc[r][j] = v; }
        if ((tid & 63) < 16) {
#pragma unroll
            for (int r = 0; r < 17; ++r) *(LAS f32x4*)(red + (wv * 17 + r) * 64 + 4 * cq) = acc[r]; }
        __syncthreads();
        for (int i = tid; i < 17 * 64; i += 512) { const int r = i >> 6, c2 = i & 63; float s2 = a.in[I_MODB][l * 6144 + cc0 + c2];
#pragma unroll
            for (int w = 0; w < 8; ++w) s2 += red[(w * 17 + r) * 64 + c2];
            MOD[(size_t)(l * 17 + r) * 6144 + cc0 + c2] = s2; }
        __syncthreads();
    }
}
__device__ __forceinline__ void p0_small(const Args& a, int gtid, int GT) {
    float* rope = (float*)(a.ws + WS_ROPE);
    for (int i = gtid; i < 1024; i += GT) { const int pos = i >> 4, f = i & 15; const double inv = pow(10000.0, -(double)f / 16.0), ang = (double)pos * inv; rope[2 * i] = (float)cos(ang); rope[2 * i + 1] = (float)sin(ang); }
    bf16_t* gw = (bf16_t*)(a.ws + WS_GW);
    for (int i = gtid; i < 2 * 2 * 8 * 64 * 64; i += GT) { const int k = i & 63, n = (i >> 6) & 63, h = (i >> 12) & 7, typ = (i >> 15) & 1, dir = i >> 16;
        const float v = a.in[typ ? I_LWI : I_LWR][(size_t)((dir * 8 + h) * 64 + k) * 64 + n]; gw[i] = (bf16_t)(cvt_pk_bf16(v, 0.f) & 0xffffu); }
}

__device__ __forceinline__ void quant_row_store(const f32x4 (&o)[4], signed char* row8, float* sc_out, int lane) {
    float mx = 0.f;
#pragma unroll
    for (int j = 0; j < 4; ++j) mx = fmaxf(fmaxf(mx, fmaxf(fabsf(o[j][0]), fabsf(o[j][1]))), fmaxf(fabsf(o[j][2]), fabsf(o[j][3])));
    mx = wave_max(mx); const float sca = (mx > 0.f) ? mx * (1.f / 127.f) : 1.f, iv = 1.f / sca;
    if (lane == 0) *sc_out = sca;
#pragma unroll
    for (int j = 0; j < 4; ++j) { unsigned pk = 0u;
#pragma unroll
        for (int e = 0; e < 4; ++e) { int qi = (int)__builtin_rintf(o[j][e] * iv); qi = qi > 127 ? 127 : (qi < -127 ? -127 : qi); pk |= ((unsigned)qi & 0xffu) << (8 * e); }
        *(unsigned*)(row8 + 256 * j + 4 * lane) = pk; }
}
__device__ __forceinline__ void p1_norm(const Args& a, int gw, int NGW, int lane) {
    const float* MOD = (const float*)(a.ws + WS_MOD); signed char* H8 = (signed char*)(a.ws + WS_H); float* SAH = (float*)(a.ws + WS_SAH); const float* g = a.in[I_NMIXG];
    for (int m0 = gw; m0 < MROWS; m0 += 3 * NGW) {
        f32x4 v[3][4];
#pragma unroll
        for (int r = 0; r < 3; ++r) { const int m = m0 + r * NGW; if (m < MROWS) { const float* xr = (m < T) ? a.in[I_X] + (size_t)m * DM : a.in[I_CTX] + (size_t)(m - T) * DM;
#pragma unroll
                for (int j = 0; j < 4; ++j) v[r][j] = *(const f32x4*)(xr + 256 * j + 4 * lane); } }
        __builtin_amdgcn_sched_barrier(0);
#pragma unroll
        for (int r = 0; r < 3; ++r) { const int m = m0 + r * NGW; if (m < MROWS) { const float* md = (m < T) ? MOD + (size_t)(m >> 11) * 6144 : MOD + (size_t)16 * 6144;
                if (m < T) {
#pragma unroll
                    for (int j = 0; j < 4; ++j) { u32x2 w; w.x = cvt_pk_bf16(v[r][j][0], v[r][j][1]); w.y = cvt_pk_bf16(v[r][j][2], v[r][j][3]); *(u32x2*)((bf16_t*)(a.ws + WS_X) + (size_t)m * DM + 256 * j + 4 * lane) = w; } }
                float s = 0.f;
#pragma unroll
                for (int j = 0; j < 4; ++j) s += (v[r][j][0] * v[r][j][0] + v[r][j][1] * v[r][j][1]) + (v[r][j][2] * v[r][j][2] + v[r][j][3] * v[r][j][3]);
                const float rstd = rsqrtf(wave_sum(s) * (1.f / DM) + EPS);
#pragma unroll
                for (int j = 0; j < 4; ++j) { const int c = 256 * j + 4 * lane; const f32x4 gg = *(const f32x4*)(g + c), sh = *(const f32x4*)(md + c), sc = *(const f32x4*)(md + 1024 + c);
                    v[r][j] = v[r][j] * rstd * gg * (sc + 1.f) + sh; }
                quant_row_store(v[r], H8 + (size_t)m * DM, SAH + m, lane); } }
    }
}

__device__ __forceinline__ void attn_phase(const Args& a, LAS unsigned char* lds, int G, int c) {
    const int tid = threadIdx.x, wid = __builtin_amdgcn_readfirstlane(tid >> 6), lane = tid & 63, l31 = lane & 31, hh = lane >> 5;
    const bf16_t* Q = (const bf16_t*)(a.ws + WS_Q); const bf16_t* Kb = (const bf16_t*)(a.ws + WS_K); const bf16_t* VT = (const bf16_t*)(a.ws + WS_VT); const bf16_t* VTC = (const bf16_t*)(a.ws + WS_VTC);
    bf16_t* Y1 = (bf16_t*)(a.ws + WS_Y1);
    constexpr int KST = 144, BUFB = 2 * 64 * KST;
    const int ldr = tid >> 3, ldc = tid & 7;
    for (int un = c; un < 512; un += G) {
        const int b = un >> 5, kvh = (un >> 4) & 1, nb = un & 15;
        const int hq = 4 * kvh + (wid >> 1), rh = wid & 1;
        const int q0 = b * SEQ + nb * 128 + rh * 64;
        bf16x8 qf[2][4];
#pragma unroll
        for (int qt = 0; qt < 2; ++qt)
#pragma unroll
            for (int s = 0; s < 4; ++s) qf[qt][s] = *(const bf16x8*)(Q + (size_t)(q0 + 32 * qt + l31) * 512 + hq * 64 + 16 * s + 8 * hh);
        f32x16 O[2][2];
#pragma unroll
        for (int i = 0; i < 2; ++i)
#pragma unroll
            for (int j = 0; j < 2; ++j)
#pragma unroll
                for (int r = 0; r < 16; ++r) O[i][j][r] = 0.f;
        const float sk = a.in[I_SINK][hq] * LOG2E;
        float mrun[2] = {sk, sk}, lrun[2] = {0.f, 0.f};
        const int t_lo = (nb == 0) ? 2 : 0, t_hi = (nb == 15) ? 4 : 6;
        int ti = t_lo, buf = 0;
        u32x4 kreg, vreg;
#define ATT_LOAD(tile) do { const int rw_ = ((tile) < 6) ? (b * SEQ + (nb - 1) * 128 + 64 * (tile) + ldr) : (T + b * CTX + 64 * ((tile) - 6) + ldr); \
            kreg = *(const u32x4*)(Kb + (size_t)rw_ * 128 + kvh * 64 + ldc * 8); vreg = *(const u32x4*)(VT + (size_t)rw_ * 128 + kvh * 64 + ldc * 8); } while (0)
#define ATT_WRITE(bf) do { *(LAS u32x4*)(lds + (bf) * BUFB + ldr * KST + ldc * 16) = kreg; \
            LAS unsigned short* vp_ = (LAS unsigned short*)(lds + (bf) * BUFB + 64 * KST + (8 * ldc) * KST + ldr * 2);     \
            _Pragma("unroll") for (int i_ = 0; i_ < 4; ++i_) { vp_[(2 * i_) * (KST / 2)] = (unsigned short)(vreg[i_] & 0xffffu); vp_[(2 * i_ + 1) * (KST / 2)] = (unsigned short)(vreg[i_] >> 16); } } while (0)
        ATT_LOAD(ti); ATT_WRITE(0);
        __syncthreads();
        for (;;) {
            int nti = ti + 1; if (nti == t_hi) nti = 6;
            if (nti < 10) ATT_LOAD(nti);
            __builtin_amdgcn_sched_barrier(0);
            const int dt = ti - rh;
            const bool part = (ti >= 6) || (dt >= 0 && dt <= 4);
            if (part) {
                const LAS unsigned char* Kt = lds + buf * BUFB; const LAS unsigned char* Vt = Kt + 64 * KST;
                f32x16 S[2][2];
#pragma unroll
                for (int i = 0; i < 2; ++i)
#pragma unroll
                    for (int j = 0; j < 2; ++j)
#pragma unroll
                        for (int r = 0; r < 16; ++r) S[i][j][r] = 0.f;
#pragma unroll
                for (int kt = 0; kt < 2; ++kt)
#pragma unroll
                    for (int s = 0; s < 4; ++s) { const bf16x8 kf = *(const LAS bf16x8*)(Kt + (32 * kt + l31) * KST + (16 * s + 8 * hh) * 2);
#pragma unroll
                        for (int qt = 0; qt < 2; ++qt) S[kt][qt] = __builtin_amdgcn_mfma_f32_32x32x16_bf16(kf, qf[qt][s], S[kt][qt], 0, 0, 0); }
                if (ti < 6 && (dt == 0 || dt == 4)) {
#pragma unroll
                    for (int kt = 0; kt < 2; ++kt)
#pragma unroll
                        for (int qt = 0; qt < 2; ++qt)
#pragma unroll
                            for (int r = 0; r < 16; ++r) { const int kk = 32 * kt + (r & 3) + 8 * (r >> 2) + 4 * hh, qq = 32 * qt + l31;
                                const bool bad = (dt == 0) ? (kk < qq) : (kk > qq); if (bad) S[kt][qt][r] = -INFINITY; }
                }
#pragma unroll
                for (int qt = 0; qt < 2; ++qt) {
                    float mx = S[0][qt][0];
#pragma unroll
                    for (int r = 1; r < 16; ++r) mx = fmaxf(mx, S[0][qt][r]);
#pragma unroll
                    for (int r = 0; r < 16; ++r) mx = fmaxf(mx, S[1][qt][r]);
                    mx = fmaxf(mx, __shfl_xor(mx, 32));
                    const float mn = fmaxf(mrun[qt], mx), al = __builtin_amdgcn_exp2f(mrun[qt] - mn); mrun[qt] = mn;
                    float ps = 0.f;
#pragma unroll
                    for (int kt = 0; kt < 2; ++kt)
#pragma unroll
                        for (int r = 0; r < 16; ++r) { const float p = __builtin_amdgcn_exp2f(S[kt][qt][r] - mn); S[kt][qt][r] = p; ps += p; }
                    lrun[qt] = lrun[qt] * al + ps;
#pragma unroll
                    for (int r = 0; r < 16; ++r) { O[0][qt][r] *= al; O[1][qt][r] *= al; }
                }
#pragma unroll
                for (int kt = 0; kt < 2; ++kt)
#pragma unroll
                    for (int s2 = 0; s2 < 2; ++s2) {
                        bf16x8 pf[2];
#pragma unroll
                        for (int qt = 0; qt < 2; ++qt) { u32x4 w; w.x = cvt_pk_bf16(S[kt][qt][8 * s2 + 0], S[kt][qt][8 * s2 + 1]); w.y = cvt_pk_bf16(S[kt][qt][8 * s2 + 2], S[kt][qt][8 * s2 + 3]);
                            w.z = cvt_pk_bf16(S[kt][qt][8 * s2 + 4], S[kt][qt][8 * s2 + 5]); w.w = cvt_pk_bf16(S[kt][qt][8 * s2 + 6], S[kt][qt][8 * s2 + 7]); pf[qt] = __builtin_bit_cast(bf16x8, w); }
#pragma unroll
                        for (int d2 = 0; d2 < 2; ++d2) { const LAS unsigned char* vp = Vt + (32 * d2 + l31) * KST + (32 * kt + 16 * s2 + 4 * hh) * 2;
                            const u32x2 v0 = *(const LAS u32x2*)vp, v1 = *(const LAS u32x2*)(vp + 16); u32x4 vv; vv.x = v0.x; vv.y = v0.y; vv.z = v1.x; vv.w = v1.y;
                            const bf16x8 vf = __builtin_bit_cast(bf16x8, vv);
#pragma unroll
                            for (int qt = 0; qt < 2; ++qt) O[d2][qt] = __builtin_amdgcn_mfma_f32_32x32x16_bf16(vf, pf[qt], O[d2][qt], 0, 0, 0); }
                    }
            }
            if (nti < 10) ATT_WRITE(buf ^ 1);
            __syncthreads();
            if (nti >= 10) break;
            ti = nti; buf ^= 1;
        }
#undef ATT_LOAD
#undef ATT_WRITE
#pragma unroll
        for (int qt = 0; qt < 2; ++qt) {
            const float lt = lrun[qt] + __shfl_xor(lrun[qt], 32) + __builtin_amdgcn_exp2f(sk - mrun[qt]); const float inv = 1.f / lt;
            unsigned char* op = (unsigned char*)Y1 + (size_t)(q0 + 32 * qt + l31) * DM + 512 + hq * 64;
#pragma unroll
            for (int d2 = 0; d2 < 2; ++d2)
#pragma unroll
                for (int g = 0; g < 4; ++g) { int w = 0; w = __builtin_amdgcn_cvt_pk_fp8_f32(O[d2][qt][4 * g] * inv, O[d2][qt][4 * g + 1] * inv, w, false); w = __builtin_amdgcn_cvt_pk_fp8_f32(O[d2][qt][4 * g + 2] * inv, O[d2][qt][4 * g + 3] * inv, w, true);
                    *(int*)(op + 32 * d2 + 8 * g + 4 * hh) = w; }
        }
    }
}

constexpr int LRU_URAW = 0, LRU_UCF = 17408, LRU_UCB = 33792, LRU_AL = 43008, LRU_BL = 75776, LRU_SEG = 108544, LRU_CAR = 112640, LRU_CARX = 114688;
template <int PASS>
__device__ __forceinline__ void lru_phase(const Args& a, LAS unsigned char* lds, int bid) {
    const int tid = threadIdx.x, wid = __builtin_amdgcn_readfirstlane(tid >> 6), lane = tid & 63, l31 = lane & 31, hh = lane >> 5;
    const int pair = bid >> 1, sub = bid & 1, b = pair >> 3, h = pair & 7;
    const bf16_t* U = (const bf16_t*)(a.ws + WS_U);
    LAS float* uraw = (LAS float*)(lds + LRU_URAW); LAS float* ucf = (LAS float*)(lds + LRU_UCF); LAS unsigned char* ucb = lds + LRU_UCB;
    LAS float* AL = (LAS float*)(lds + LRU_AL); LAS float* BL = (LAS float*)(lds + LRU_BL); LAS float* SEG = (LAS float*)(lds + LRU_SEG); LAS float* CAR = (LAS float*)(lds + LRU_CAR);
    LAS float* CARX = (LAS float*)(lds + LRU_CARX);
    const int ct = tid >> 3, ccg = tid & 7;
    float cw[4][8], cb[8];
#pragma unroll
    for (int j = 0; j < 8; ++j) { cb[j] = a.in[I_LCB][h * 64 + ccg * 8 + j];
#pragma unroll
        for (int k = 0; k < 4; ++k) cw[k][j] = a.in[I_LCW][k * 512 + h * 64 + ccg * 8 + j]; }
    const int gdir = wid & 1, gnt = (wid >> 1) & 1, gth = wid >> 2;
    bf16x8 gbr[4], gbi[4];
    { const bf16_t* gwr = (const bf16_t*)(a.ws + WS_GW) + (size_t)(((gdir * 2 + 0) * 8 + h) * 64 + 32 * gnt + l31) * 64 + 8 * hh; const bf16_t* gwi = gwr + (size_t)8 * 64 * 64;
#pragma unroll
        for (int s = 0; s < 4; ++s) { gbr[s] = *(const bf16x8*)(gwr + 16 * s); gbi[s] = *(const bf16x8*)(gwi + 16 * s); } }
    const int chl = 32 * gnt + l31, chg = h * 64 + chl;
    const float brr = a.in[I_LBR][gdir * 512 + chg], bii = a.in[I_LBI][gdir * 512 + chg];
    const float sp8 = -8.f * log1pf(expf(-a.in[I_LLAM][gdir * 512 + chg]));
    const int dir = tid >> 8, seg = (tid >> 6) & 3, ch = tid & 63;
    if (PASS == 2) {
        const f32x2* AG = (const f32x2*)(a.ws + WS_AG); LAS f32x2* agl = (LAS f32x2*)(lds + LRU_AL);
        f32x2 v[9];
#pragma unroll
        for (int i = 0; i < 9; ++i) { const int q = tid + i * 512, d2 = q / 2304, r = q % 2304, ck = r >> 6, c2 = r & 63; v[i] = AG[(size_t)((b * 2 + d2) * 36 + ck) * 512 + h * 64 + c2]; }
#pragma unroll
        for (int i = 0; i < 9; ++i) agl[tid + i * 512] = v[i];
        __syncthreads();
        if (tid < 128) { const int d2 = tid >> 6, c2 = tid & 63; const LAS f32x2* ag = agl + d2 * 2304 + c2; LAS float* cx = CARX + d2 * 2048 + c2; float H = 0.f;
            if (d2 == 0) { for (int k = 0; k < 4; ++k) { const f32x2 g = ag[k * 64]; H = g[0] * H + g[1]; } for (int j = 0; j < 32; ++j) { cx[j * 64] = H; const f32x2 g = ag[(4 + j) * 64]; H = g[0] * H + g[1]; } }
            else { for (int k = 3; k >= 0; --k) { const f32x2 g = ag[k * 64]; H = g[0] * H + g[1]; } for (int j = 31; j >= 0; --j) { cx[j * 64] = H; const f32x2 g = ag[(4 + j) * 64]; H = g[0] * H + g[1]; } } }
        __syncthreads();
    }
    const int nun = (PASS == 1) ? 18 : 16;
    u32x4 pre0, pre1; bool ok0, ok1;
#define LRU_CHUNK(it) (((PASS == 1) ? 0 : 4) + sub + 2 * (it))
#define LRU_PREFETCH(ck_) do { const bool isx_ = (ck_) >= 4; const int rb_ = isx_ ? b * SEQ : T + b * CTX, sl_ = isx_ ? SEQ : CTX, pp_ = (isx_ ? ((ck_) - 4) * 64 : (ck_) * 64) - 2; \
        { const int r_ = tid >> 3, p_ = pp_ + r_; ok0 = (p_ >= 0 && p_ < sl_); if (ok0) pre0 = *(const u32x4*)(U + (size_t)(rb_ + p_) * 512 + h * 64 + (tid & 7) * 8); } \
        { const int r_ = 64 + (tid >> 3), p_ = pp_ + r_; ok1 = (tid < 24) && (p_ >= 0 && p_ < sl_); if (ok1) pre1 = *(const u32x4*)(U + (size_t)(rb_ + p_) * 512 + h * 64 + (tid & 7) * 8); } } while (0)
#define LRU_UNPACK(PW, okf, dst) do { f32x4 lo_ = {0.f, 0.f, 0.f, 0.f}, hi_ = lo_; if (okf) { const u32x4 pw_ = (PW); lo_ = (f32x4){bf_lo(pw_[0]), bf_hi(pw_[0]), bf_lo(pw_[1]), bf_hi(pw_[1])}; hi_ = (f32x4){bf_lo(pw_[2]), bf_hi(pw_[2]), bf_lo(pw_[3]), bf_hi(pw_[3])}; } \
        *(LAS f32x4*)(dst) = lo_; *(LAS f32x4*)((dst) + 4) = hi_; } while (0)
    LRU_PREFETCH(LRU_CHUNK(0));
    LRU_UNPACK(pre0, ok0, uraw + (tid >> 3) * 64 + (tid & 7) * 8); if (tid < 24) LRU_UNPACK(pre1, ok1, uraw + (64 + (tid >> 3)) * 64 + (tid & 7) * 8);
    __syncthreads();
    for (int it = 0; it < nun; ++it) {
        const int ck = LRU_CHUNK(it);
        const bool isx = ck >= 4; const int rowbase = isx ? b * SEQ : T + b * CTX, p0 = isx ? (ck - 4) * 64 : ck * 64;
        if (it + 1 < nun) LRU_PREFETCH(LRU_CHUNK(it + 1));
        u32x4 gw4 = {0u, 0u, 0u, 0u};
        if (PASS == 2) gw4 = *(const u32x4*)((const bf16_t*)(a.ws + WS_G) + (size_t)(rowbase + p0 + ct) * 512 + h * 64 + ccg * 8);
        { float o[8];
#pragma unroll
            for (int j = 0; j < 8; ++j) o[j] = cb[j];
#pragma unroll
            for (int k = 0; k < 4; ++k) { const f32x4 u0 = *(const LAS f32x4*)(uraw + (ct + k) * 64 + ccg * 8), u1 = *(const LAS f32x4*)(uraw + (ct + k) * 64 + ccg * 8 + 4);
#pragma unroll
                for (int j = 0; j < 4; ++j) { o[j] += cw[k][j] * u0[j]; o[4 + j] += cw[k][4 + j] * u1[j]; } }
            *(LAS f32x4*)(ucf + ct * 64 + ccg * 8) = (f32x4){o[0], o[1], o[2], o[3]}; *(LAS f32x4*)(ucf + ct * 64 + ccg * 8 + 4) = (f32x4){o[4], o[5], o[6], o[7]};
            u32x4 w; w.x = cvt_pk_bf16(o[0], o[1]); w.y = cvt_pk_bf16(o[2], o[3]); w.z = cvt_pk_bf16(o[4], o[5]); w.w = cvt_pk_bf16(o[6], o[7]);
            *(LAS u32x4*)(ucb + ct * 144 + ccg * 16) = w; }
        BAR_LDS();
        if (it + 1 < nun) { LRU_UNPACK(pre0, ok0, uraw + (tid >> 3) * 64 + (tid & 7) * 8); if (tid < 24) LRU_UNPACK(pre1, ok1, uraw + (64 + (tid >> 3)) * 64 + (tid & 7) * 8); }
        { f32x16 ar, ai;
#pragma unroll
            for (int r = 0; r < 16; ++r) { ar[r] = 0.f; ai[r] = 0.f; }
#pragma unroll
            for (int s = 0; s < 4; ++s) { const bf16x8 af = *(const LAS bf16x8*)(ucb + (32 * gth + l31) * 144 + (16 * s + 8 * hh) * 2);
                ar = __builtin_amdgcn_mfma_f32_32x32x16_bf16(af, gbr[s], ar, 0, 0, 0); ai = __builtin_amdgcn_mfma_f32_32x32x16_bf16(af, gbi[s], ai, 0, 0, 0); }
#pragma unroll
            for (int r = 0; r < 16; ++r) { const int tk = 32 * gth + (r & 3) + 8 * (r >> 2) + 4 * hh;
                const float rg = sigm(ar[r] + brr), ig = sigm(ai[r] + bii), la = sp8 * rg, av = __expf(la), mult = __builtin_amdgcn_sqrtf(fmaxf(1.f - av * av, 0.f));
                AL[gdir * 4096 + tk * 64 + chl] = av; BL[gdir * 4096 + tk * 64 + chl] = mult * ig * ucf[tk * 64 + chl]; } }
        BAR_LDS();
        LAS float* al = AL + dir * 4096 + ch; LAS float* bl = BL + dir * 4096 + ch;
        { float hs = 0.f, P = 1.f;
#pragma unroll
            for (int jj = 0; jj < 16; ++jj) { const int j = 16 * seg + jj, tk = dir ? 63 - j : j; const float av = al[tk * 64], bv = bl[tk * 64]; hs = av * hs + bv; P *= av;
                if (PASS == 2) { bl[tk * 64] = hs; al[tk * 64] = P; } }
            SEG[((dir * 4 + seg) * 64 + ch) * 2] = P; SEG[((dir * 4 + seg) * 64 + ch) * 2 + 1] = hs; }
        BAR_LDS();
        if (PASS == 1) {
            if (seg == 0) { float H = 0.f, A = 1.f;
#pragma unroll
                for (int s = 0; s < 4; ++s) { const float P = SEG[((dir * 4 + s) * 64 + ch) * 2], hs = SEG[((dir * 4 + s) * 64 + ch) * 2 + 1]; H = P * H + hs; A *= P; }
                f32x2* AG = (f32x2*)(a.ws + WS_AG); AG[(size_t)((b * 2 + dir) * 36 + ck) * 512 + h * 64 + ch] = (f32x2){A, H}; }
        } else {
            if (seg == 0) { float cv = CARX[dir * 2048 + (ck - 4) * 64 + ch];
#pragma unroll
                for (int s = 0; s < 4; ++s) { CAR[(dir * 4 + s) * 64 + ch] = cv; const float P = SEG[((dir * 4 + s) * 64 + ch) * 2], hs = SEG[((dir * 4 + s) * 64 + ch) * 2 + 1]; cv = P * cv + hs; } }
            BAR_LDS();
            { const float cs = CAR[(dir * 4 + seg) * 64 + ch];
#pragma unroll
                for (int jj = 0; jj < 16; ++jj) { const int j = 16 * seg + jj, tk = dir ? 63 - j : j; bl[tk * 64] += al[tk * 64] * cs; } }
            BAR_LDS();
            { float gv[8] = {bf_lo(gw4.x), bf_hi(gw4.x), bf_lo(gw4.y), bf_hi(gw4.y), bf_lo(gw4.z), bf_hi(gw4.z), bf_lo(gw4.w), bf_hi(gw4.w)};
                float o[8];
#pragma unroll
                for (int j = 0; j < 8; ++j) { const float rec = BL[ct * 64 + ccg * 8 + j] + BL[4096 + ct * 64 + ccg * 8 + j]; const float x = gv[j];
                    const float ge = x * sigm(1.5957691216f * (x + 0.044715f * x * x * x)); o[j] = ge * rec; }
                *(u32x2*)((unsigned char*)(a.ws + WS_Y1) + (size_t)(rowbase + p0 + ct) * DM + h * 64 + ccg * 8) = pack8_fp8((f32x4){o[0], o[1], o[2], o[3]}, (f32x4){o[4], o[5], o[6], o[7]}); }
        }
        BAR_LDS();
    }
#undef LRU_CHUNK
#undef LRU_PREFETCH
#undef LRU_UNPACK
}

constexpr int RT_HT = 0, RT_LG = 0, RT_LCNT = 132096, RT_LBASE = 133120, RT_LE = 134144, RT_LR = 138240, RT_LW = 142336, RT_GS = 146432;
__device__ __forceinline__ void router_phase(const Args& a, LAS unsigned char* lds, int l, int bid, int G, int commit) {
    const int tid = threadIdx.x, wid = __builtin_amdgcn_readfirstlane(tid >> 6), lane = tid & 63, l31 = lane & 31, hh = lane >> 5;
    const bf16_t* X = (const bf16_t*)(a.ws + WS_X); const float* SSQ = (const float*)(a.ws + WS_SSQ); const float* MOD = (const float*)(a.ws + WS_MOD) + (size_t)l * 17 * 6144;
    signed char* H8 = (signed char*)(a.ws + WS_H); float* SA = (float*)(a.ws + WS_SA); const bf16_t* RT = (const bf16_t*)(a.ws + WS_RT) + (size_t)l * 256 * 1024;
    const float* gff = a.in[I_NFFNG] + l * DM; const float* rbias = a.in[I_RB] + l * NEXP;
    LAS unsigned char* HT = lds + RT_HT; LAS float* LG = (LAS float*)(lds + RT_LG); LAS unsigned* LCNT = (LAS unsigned*)(lds + RT_LCNT); LAS unsigned* LBASE = (LAS unsigned*)(lds + RT_LBASE);
    LAS int* LE = (LAS int*)(lds + RT_LE); LAS int* LR = (LAS int*)(lds + RT_LR); LAS float* LW = (LAS float*)(lds + RT_LW);
    { int* st = (int*)(a.ws + WS_SLOT_TOK); float* sg = (float*)(a.ws + WS_SLOT_GATE); float* ssa = (float*)(a.ws + WS_SLOT_SA); for (int i = bid * 512 + tid; i < MAXSLOT; i += G * 512) { st[i] = 0; sg[i] = 0.f; ssa[i] = 0.f; } }
    if (tid < 256) LCNT[tid] = 0u;
    __syncthreads();
    const int t0 = bid * 128;
    for (int pair = 0; pair < 2; ++pair) {
        { const int tb = t0 + pair * 64 + wid * 4, b = tb >> 11; const float* md = MOD + (size_t)b * 6144;
            f32x4 gg[4], sh[4], sc[4];
#pragma unroll
            for (int j = 0; j < 4; ++j) { const int c = 256 * j + 4 * lane; gg[j] = *(const f32x4*)(gff + c); sh[j] = *(const f32x4*)(md + 3 * 1024 + c); sc[j] = *(const f32x4*)(md + 4 * 1024 + c) + 1.f; }
            u32x2 raw[2][4][4]; float ssl[2][4];
#define RT_XLOAD(r_) do { _Pragma("unroll") for (int q = 0; q < 4; ++q) { const int t = tb + 32 * (r_) + q; ssl[r_][q] = (lane < 16) ? SSQ[(size_t)t * 16 + lane] : 0.f; \
                _Pragma("unroll") for (int j = 0; j < 4; ++j) raw[r_][q][j] = *(const u32x2*)(X + (size_t)t * DM + 256 * j + 4 * lane); } } while (0)
            RT_XLOAD(0);
#pragma unroll
            for (int r = 0; r < 2; ++r) {
                if (r == 0) RT_XLOAD(1);
                __builtin_amdgcn_sched_barrier(0);
#pragma unroll
                for (int q = 0; q < 4; ++q) { const int tl = 32 * r + wid * 4 + q, t = tb + 32 * r + q;
                    const float rstd = rsqrtf(wave_sum(ssl[r][q]) * (1.f / DM) + EPS); f32x4 ov[4];
#pragma unroll
                    for (int j = 0; j < 4; ++j) { const int c = 256 * j + 4 * lane; const u32x2 w0 = raw[r][q][j]; const f32x4 xq = {bf_lo(w0.x), bf_hi(w0.x), bf_lo(w0.y), bf_hi(w0.y)};
                        const f32x4 o = xq * rstd * gg[j] * sc[j] + sh[j]; ov[j] = o; u32x2 w; w.x = cvt_pk_bf16(o[0], o[1]); w.y = cvt_pk_bf16(o[2], o[3]);
                        *(LAS u32x2*)(HT + tl * 2064 + c * 2) = w; }
                    quant_row_store(ov, H8 + (size_t)t * DM, SA + t, lane); }
                __builtin_amdgcn_sched_barrier(0); } }
#undef RT_XLOAD
        __syncthreads();
        if (commit == 3) continue;
        { f32x16 acc[2][2];
#pragma unroll
            for (int r = 0; r < 16; ++r) { acc[0][0][r] = 0.f; acc[0][1][r] = 0.f; acc[1][0][r] = 0.f; acc[1][1][r] = 0.f; }
            const GAS char* bps = (const GAS char*)((const char*)RT + (size_t)wid * 65536); asm volatile("" : "+s"(bps));
            const unsigned bvo = (unsigned)lane * 16u; const LAS unsigned char* ap = HT + l31 * 2064 + 16 * hh;
            const LAS unsigned char* ap1 = ap + 32 * 2064; asm volatile("" : "+v"(ap1));
            bf16x8 bq[3][8];
#pragma unroll
            for (int i = 0; i < 8; ++i) bq[0][i] = *(const GAS bf16x8*)(bps + 1024 * i + bvo);
#pragma unroll
            for (int i = 0; i < 8; ++i) bq[1][i] = *(const GAS bf16x8*)(bps + 1024 * (8 + i) + bvo);
            __builtin_amdgcn_sched_barrier(0);
#pragma unroll
            for (int g = 0; g < 8; ++g) {
                if (g < 6) {
#pragma unroll
                    for (int i = 0; i < 8; ++i) bq[(g + 2) % 3][i] = *(const GAS bf16x8*)(bps + 1024 * (8 * (g + 2) + i) + bvo); }
                __builtin_amdgcn_sched_barrier(0);
#pragma unroll
                for (int i = 0; i < 8; ++i) { const bf16x8 a0 = *(const LAS bf16x8*)(ap + 32 * (8 * g + i)), a1 = *(const LAS bf16x8*)(ap1 + 32 * (8 * g + i));
                    acc[0][i & 1] = __builtin_amdgcn_mfma_f32_32x32x16_bf16(a0, bq[g % 3][i], acc[0][i & 1], 0, 0, 0); acc[1][i & 1] = __builtin_amdgcn_mfma_f32_32x32x16_bf16(a1, bq[g % 3][i], acc[1][i & 1], 0, 0, 0); }
                __builtin_amdgcn_sched_barrier(0); }
            __syncthreads();
#pragma unroll
            for (int h2 = 0; h2 < 2; ++h2)
#pragma unroll
                for (int r = 0; r < 16; ++r) LG[(32 * h2 + (r & 3) + 8 * (r >> 2) + 4 * hh) * 257 + 32 * wid + l31] = acc[h2][0][r] + acc[h2][1][r]; }
        __syncthreads();
        if (commit == 2) continue;
        for (int rr = 0; rr < 2; ++rr)
        { const int rw = lane >> 4, li = lane & 15, tl = 32 * rr + wid * 4 + rw, e0 = 16 * li;
            float cand[16];
#pragma unroll
            for (int j4 = 0; j4 < 4; ++j4) { const f32x4 rb4 = *(const f32x4*)(rbias + e0 + 4 * j4);
#pragma unroll
                for (int j = 0; j < 4; ++j) cand[4 * j4 + j] = sigm(LG[tl * 257 + e0 + 4 * j4 + j]) + rb4[j]; }
            float m1 = fmaxf(cand[0], cand[1]), m2 = fminf(cand[0], cand[1]);
#pragma unroll
            for (int j = 2; j < 16; ++j) { const float v = cand[j]; m2 = fmaxf(m2, fminf(m1, v)); m1 = fmaxf(m1, v); }
            { const float o1 = dppf<DPP_XOR1, 0xF, true>(0.f, m1), o2 = dppf<DPP_XOR1, 0xF, true>(0.f, m2); const float n1 = fmaxf(m1, o1), n2 = fmaxf(fminf(m1, o1), fmaxf(m2, o2)); m1 = n1; m2 = n2; }
            const float gs = m1 + m2; const int mg = li >> 1;
            LAS float* GS = (LAS float*)(lds + RT_GS) + tl * 8;
            if ((li & 1) == 0) GS[mg] = gs;
            LDS_WAIT(); asm volatile("" ::: "memory");
            int rank = 0;
            { const f32x4 g0 = *(const LAS f32x4*)GS, g1 = *(const LAS f32x4*)(GS + 4);
#pragma unroll
                for (int g2 = 0; g2 < 8; ++g2) { const float v = g2 < 4 ? g0[g2 & 3] : g1[g2 & 3]; rank += (v > gs || (v == gs && g2 < mg)) ? 1 : 0; } }
            if (rank >= 4) {
#pragma unroll
                for (int j = 0; j < 16; ++j) cand[j] = -INFINITY; }
            int my_e = 0; float my_s = 0.f, tot = 0.f;
            for (int k = 0; k < 8; ++k) {
                float tv[8]; int te[8];
#pragma unroll
                for (int j = 0; j < 8; ++j) { const bool hi = cand[2 * j + 1] > cand[2 * j]; tv[j] = hi ? cand[2 * j + 1] : cand[2 * j]; te[j] = hi ? 2 * j + 1 : 2 * j; }
#pragma unroll
                for (int w = 4; w >= 1; w >>= 1)
#pragma unroll
                    for (int j = 0; j < w; ++j) { const bool hi = tv[j + w] > tv[j]; tv[j] = hi ? tv[j + w] : tv[j]; te[j] = hi ? te[j + w] : te[j]; }
                float bv = tv[0]; int be = e0 + te[0];
#define RT_STEP(CTRL) do { const float ov = dppf<CTRL, 0xF, false>(-INFINITY, bv); const int oe = dppi<CTRL, 0xF, false>(0x7fffffff, be); \
                    const bool tk = (ov > bv || (ov == bv && oe < be)); bv = tk ? ov : bv; be = tk ? oe : be; } while (0)
                RT_STEP(DPP_XOR1); RT_STEP(DPP_XOR2); RT_STEP(DPP_ROR4); RT_STEP(DPP_ROR8);
#undef RT_STEP
                const float bs = sigm(LG[tl * 257 + be]);
                tot += bs;
                if (li == k) { my_e = be; my_s = bs; }
#pragma unroll
                for (int j = 0; j < 16; ++j) cand[j] = (e0 + j == be) ? -INFINITY : cand[j];
            }
            if (li < 8) { const unsigned lr = __hip_atomic_fetch_add(&LCNT[my_e], 1u, __ATOMIC_RELAXED, __HIP_MEMORY_SCOPE_WORKGROUP); const int ix = (pair * 64 + tl) * 8 + li; LE[ix] = my_e; LR[ix] = (int)lr; LW[ix] = 2.5f * my_s / tot; }
        }
        __syncthreads();
    }
    if (commit != 1) return;
    if (tid < 256) { const unsigned n = LCNT[tid]; unsigned base = 0u; if (n) base = __hip_atomic_fetch_add((unsigned*)(a.ws + WS_CTL) + CW_CNT + (l * 256 + tid) * 64, n, __ATOMIC_RELAXED, __HIP_MEMORY_SCOPE_AGENT); LBASE[tid] = base; }
    __syncthreads();
    { int* TE = (int*)(a.ws + WS_TOK_E); int* TR = (int*)(a.ws + WS_TOK_R); float* TW = (float*)(a.ws + WS_TOK_W);
        for (int i = tid; i < 1024; i += 512) { const int e = LE[i]; TE[(size_t)t0 * 8 + i] = e; TR[(size_t)t0 * 8 + i] = (int)LBASE[e] + LR[i]; TW[(size_t)t0 * 8 + i] = LW[i]; } }
    __syncthreads();
}

__device__ __forceinline__ int build_tables(const Args& a, LAS unsigned char* lds, int l) {
    const int tid = threadIdx.x;
    LAS int* PB = (LAS int*)(lds + LDS_PB_OFF); LAS unsigned short* BLKE = (LAS unsigned short*)(lds + LDS_BLKE_OFF);
    LAS int* NBK = (LAS int*)(lds + LDS_IDX_OFF);
    if (tid < 256) { const unsigned n = __hip_atomic_load((unsigned*)(a.ws + WS_CTL) + CW_CNT + (l * 256 + tid) * 64, __ATOMIC_RELAXED, __HIP_MEMORY_SCOPE_AGENT); NBK[tid] = (int)((n + 255u) >> 8); }
    __syncthreads();
    LAS int* GT16 = NBK + 256;
    if (tid < 16) { int s = 0;
#pragma unroll
        for (int j = 0; j < 16; ++j) s += NBK[16 * tid + j]; GT16[tid] = s; }
    __syncthreads();
    if (tid < 256) { int s = 0; const int gq = tid >> 4, r = tid & 15;
#pragma unroll
        for (int j = 0; j < 16; ++j) { s += (j < gq) ? GT16[j] : 0; s += (j < r) ? NBK[16 * gq + j] : 0; }
        PB[tid] = s; if (tid == 255) { PB[256] = s + NBK[255]; } }
    __syncthreads();
    const int nbr = PB[256];
    if (tid < 256) { const int s = PB[tid], n = NBK[tid]; for (int i = 0; i < n; ++i) BLKE[s + i] = (unsigned short)tid; }
    if (tid < 128) BLKE[nbr + tid] = 256;
    __syncthreads();
    return nbr;
}
__device__ __forceinline__ void slots_phase(const Args& a, LAS unsigned char* lds, int l, int bid) {
    const int tid = threadIdx.x;
    const int nbr = build_tables(a, lds, l);
    LAS int* PB = (LAS int*)(lds + LDS_PB_OFF);
    const int* TE = (const int*)(a.ws + WS_TOK_E); const int* TR = (const int*)(a.ws + WS_TOK_R); const float* TW = (const float*)(a.ws + WS_TOK_W);
    int* TS = (int*)(a.ws + WS_TOK_SLOT); int* ST = (int*)(a.ws + WS_SLOT_TOK); float* SG = (float*)(a.ws + WS_SLOT_GATE); float* SSA = (float*)(a.ws + WS_SLOT_SA); const float* SA = (const float*)(a.ws + WS_SA);
    const int t0 = bid * 128;
    for (int i = tid; i < 1024; i += 512) { const size_t ix = (size_t)t0 * 8 + i; const int e = TE[ix], slot = 256 * PB[e] + TR[ix]; ST[slot] = t0 + (i >> 3); SG[slot] = TW[ix]; SSA[slot] = SA[t0 + (i >> 3)]; TS[ix] = slot; }
    if (tid < 128) { const int slot = 256 * nbr + t0 + tid; ST[slot] = t0 + tid; SG[slot] = 1.f; SSA[slot] = SA[t0 + tid]; }
    if (bid == 0 && tid == 0) *((int*)(a.ws + WS_CTL) + CW_NBR + l * 64) = nbr;
    __syncthreads();
}

__device__ __forceinline__ void combine_phase(const Args& a, int l, int gw, int NGW, int lane) {
    const unsigned char* Y = (const unsigned char*)(a.ws + WS_Y); const int* TS = (const int*)(a.ws + WS_TOK_SLOT); bf16_t* X = (bf16_t*)(a.ws + WS_X); bf16_t* H = (bf16_t*)(a.ws + WS_H);
    const float* MOD = (const float*)(a.ws + WS_MOD);
    const int nbr = *((const int*)(a.ws + WS_CTL) + CW_NBR + l * 64);
    typedef float f2 __attribute__((ext_vector_type(2)));
    const int c0 = 16 * lane;
    const int cb = (lane >> 4) * 256 + ((lane >> 2) & 3) * 32 + (lane & 3) * 8;
#define CQ(q) (cb + ((q) >> 1) * 128 + ((q) & 1) * 4)
    u32x4 yw[1][9]; u32x4 xw[1][2];
#define CMB_SLOTS(t_) (((lane < 8) ? TS[(size_t)(t_) * 8 + lane] : (256 * nbr + (t_))))
#define CMB_LOAD(buf, t_, ms_) do { _Pragma("unroll") for (int k = 0; k < 9; ++k) { const int slot = __builtin_amdgcn_readlane((ms_), k); yw[buf][k] = *(const u32x4*)(Y + (size_t)slot * DM + c0); } \
        xw[buf][0] = *(const u32x4*)(X + (size_t)(t_) * DM + cb); xw[buf][1] = *(const u32x4*)(X + (size_t)(t_) * DM + cb + 128); } while (0)
#define CMB_BODY(buf, t_) do { const int b = (t_) >> 11; float acc[16]; \
        _Pragma("unroll") for (int j = 0; j < 16; ++j) acc[j] = 0.f; \
        _Pragma("unroll") for (int k = 0; k < 9; ++k) _Pragma("unroll") for (int d = 0; d < 4; ++d) { const f2 lo = __builtin_amdgcn_cvt_pk_f32_fp8((int)yw[buf][k][d], false), hi = __builtin_amdgcn_cvt_pk_f32_fp8((int)yw[buf][k][d], true); \
            acc[4 * d] += lo[0]; acc[4 * d + 1] += lo[1]; acc[4 * d + 2] += hi[0]; acc[4 * d + 3] += hi[1]; } \
        const float* g5 = MOD + (size_t)(l * 17 + b) * 6144 + 5 * 1024; float xn[16]; float ss = 0.f; \
        _Pragma("unroll") for (int q = 0; q < 4; ++q) { const f32x4 gv = *(const f32x4*)(g5 + CQ(q)); \
            const unsigned xa = xw[buf][q >> 1][(q & 1) * 2], xb = xw[buf][q >> 1][(q & 1) * 2 + 1]; const f32x4 xq = {bf_lo(xa), bf_hi(xa), bf_lo(xb), bf_hi(xb)}; \
            _Pragma("unroll") for (int j = 0; j < 4; ++j) { const float v = xq[j] + gv[j] * (acc[4 * q + j] * 0.0625f); xn[4 * q + j] = v; ss += v * v; } } \
        const float rstd = rsqrtf(wave_sum(ss) * (1.f / DM) + EPS); \
        if (l == 0) { const float* g1 = a.in[I_NMIXG] + DM; const float* md = MOD + (size_t)(17 + b) * 6144; float o[16]; \
            _Pragma("unroll") for (int q = 0; q < 4; ++q) { const int c = CQ(q); const f32x4 gg = *(const f32x4*)(g1 + c), sh = *(const f32x4*)(md + c), sc = *(const f32x4*)(md + 1024 + c); \
                { u32x2 wx; wx.x = cvt_pk_bf16(xn[4 * q], xn[4 * q + 1]); wx.y = cvt_pk_bf16(xn[4 * q + 2], xn[4 * q + 3]); *(u32x2*)(X + (size_t)(t_) * DM + c) = wx; } \
                _Pragma("unroll") for (int j = 0; j < 4; ++j) o[4 * q + j] = xn[4 * q + j] * rstd * gg[j] * (sc[j] + 1.f) + sh[j]; } \
            float mx = 0.f; _Pragma("unroll") for (int j = 0; j < 16; ++j) mx = fmaxf(mx, fabsf(o[j])); \
            mx = wave_max(mx); const float sca = (mx > 0.f) ? mx * (1.f / 127.f) : 1.f, iv = 1.f / sca; \
            if (lane == 0) ((float*)(a.ws + WS_SAH))[(t_)] = sca; \
            u32x4 w8; _Pragma("unroll") for (int d = 0; d < 4; ++d) { unsigned pk = 0u; \
                _Pragma("unroll") for (int e = 0; e < 4; ++e) { int qi = (int)__builtin_rintf(o[4 * d + e] * iv); qi = qi > 127 ? 127 : (qi < -127 ? -127 : qi); pk |= ((unsigned)qi & 0xffu) << (8 * e); } w8[d] = pk; } \
            *(u32x2*)((signed char*)H + (size_t)(t_) * DM + cb) = (u32x2){w8[0], w8[1]}; *(u32x2*)((signed char*)H + (size_t)(t_) * DM + cb + 128) = (u32x2){w8[2], w8[3]}; \
        } else { const float* gf = a.in[I_FING]; \
            _Pragma("unroll") for (int q = 0; q < 4; ++q) { const int c = CQ(q); const f32x4 gg = *(const f32x4*)(gf + c); \
                *(f32x4*)(a.out + (size_t)(t_) * DM + c) = (f32x4){xn[4 * q] * rstd * gg[0], xn[4 * q + 1] * rstd * gg[1], xn[4 * q + 2] * rstd * gg[2], xn[4 * q + 3] * rstd * gg[3]}; } } } while (0)
    int ms = (gw < T) ? CMB_SLOTS(gw) : 0;
    for (int t = gw; t < T; t += NGW) {
        CMB_LOAD(0, t, ms);
        if (t + NGW < T) ms = CMB_SLOTS(t + NGW);
        __builtin_amdgcn_sched_barrier(0);
        CMB_BODY(0, t);
        __builtin_amdgcn_sched_barrier(0);
    }
#undef CQ
#undef CMB_SLOTS
#undef CMB_LOAD
#undef CMB_BODY
}

__device__ __forceinline__ void conv_phase(const Args& a, LAS unsigned char* lds, int bid, int G) {
    const int tid = threadIdx.x, wid = __builtin_amdgcn_readfirstlane(tid >> 6), lane = tid & 63;
    const bf16_t* GL = (const bf16_t*)(a.ws + WS_GL); bf16_t* ZC = (bf16_t*)(a.ws + WS_ZC);
    LAS float* RED = (LAS float*)(lds + 62 * 2048);
    const int c0 = 2 * tid;
    f32x2 wk[31];
#pragma unroll
    for (int k = 0; k < 31; ++k) wk[k] = *(const f32x2*)(a.in[I_CMDWW] + k * DM + c0);
    const f32x2 bia = *(const f32x2*)(a.in[I_CMDWB] + c0), lng = *(const f32x2*)(a.in[I_CMLNG] + c0), lnb = *(const f32x2*)(a.in[I_CMLNB] + c0);
    u32x4 pre[16];
#define CONV_LOAD(tile_) do { const int b_ = (tile_) >> 6, p0_ = ((tile_) & 63) * 32; _Pragma("unroll") for (int i = 0; i < 16; ++i) { const int q = i * 512 + tid, r = q >> 7, cg = q & 127, p = p0_ - 15 + r; \
            pre[i] = (u32x4){0u, 0u, 0u, 0u}; if (q < 62 * 128 && p >= 0 && p < SEQ) pre[i] = *(const u32x4*)(GL + (size_t)(b_ * SEQ + p) * DM + cg * 8); } } while (0)
    if (bid < T / 32) CONV_LOAD(bid);
    for (int tile = bid; tile < T / 32; tile += G) {
        const int b = tile >> 6, p0 = (tile & 63) * 32;
#pragma unroll
        for (int i = 0; i < 16; ++i) { const int q = i * 512 + tid; if (q < 62 * 128) *(LAS u32x4*)(lds + q * 16) = pre[i]; }
        if (tile + G < T / 32) CONV_LOAD(tile + G);
        __builtin_amdgcn_sched_barrier(0);
        BAR_LDS();
        for (int tb = 0; tb < 4; ++tb) {
            f32x2 z[8];
#pragma unroll
            for (int j = 0; j < 8; ++j) z[j] = bia;
#pragma unroll
            for (int r = 0; r < 38; ++r) { const unsigned u = *(const LAS unsigned*)(lds + (8 * tb + r) * 2048 + c0 * 2); const f32x2 v = {bf_lo(u), bf_hi(u)};
#pragma unroll
                for (int j = 0; j < 8; ++j) { const int k = r - j; if (k >= 0 && k < 31) z[j] = __builtin_elementwise_fma(wk[k], v, z[j]); } }
            float z0[8], z1[8];
#pragma unroll
            for (int j = 0; j < 8; ++j) { z0[j] = z[j][0]; z1[j] = z[j][1]; }
            float st[16];
#pragma unroll
            for (int j = 0; j < 8; ++j) { st[2 * j] = z0[j] + z1[j]; st[2 * j + 1] = z0[j] * z0[j] + z1[j] * z1[j]; }
#pragma unroll
            for (int i = 0; i < 16; ++i) st[i] = wave_sum(st[i]);
            if (lane == 0) {
#pragma unroll
                for (int i = 0; i < 4; ++i) *(LAS f32x4*)(RED + wid * 16 + 4 * i) = (f32x4){st[4 * i], st[4 * i + 1], st[4 * i + 2], st[4 * i + 3]}; }
            BAR_LDS();
            if (tid < 16) { float t = 0.f;
#pragma unroll
                for (int w = 0; w < 8; ++w) t += RED[w * 16 + tid];
                RED[128 + tid] = t; }
            BAR_LDS();
            float tt[16];
#pragma unroll
            for (int i = 0; i < 4; ++i) { const f32x4 v = *(const LAS f32x4*)(RED + 128 + 4 * i); tt[4 * i] = v[0]; tt[4 * i + 1] = v[1]; tt[4 * i + 2] = v[2]; tt[4 * i + 3] = v[3]; }
#pragma unroll
            for (int j = 0; j < 8; ++j) { const float s1 = tt[2 * j], s2 = tt[2 * j + 1];
                const float mu = s1 * (1.f / DM), var = fmaxf(s2 * (1.f / DM) - mu * mu, 0.f), rstd = rsqrtf(var + EPS);
                const float y0 = (z0[j] - mu) * rstd * lng[0] + lnb[0], y1 = (z1[j] - mu) * rstd * lng[1] + lnb[1];
                *(unsigned short*)((unsigned char*)ZC + (size_t)(b * SEQ + p0 + 8 * tb + j) * DM + c0) = (unsigned short)__builtin_amdgcn_cvt_pk_fp8_f32(y0 * sigm(y0), y1 * sigm(y1), 0, false); }
            BAR_LDS();
        }
    }
}

#undef CONV_LOAD
struct Ctx { int tid, lane, wave, G, bid, vcu, gw, NGW; };
__device__ __forceinline__ void ph_inproj(const Args& args, LAS unsigned char* lds, const Ctx& c) {
    unsigned char* ws = args.ws;
    pg8::DenseOrder S; S.init(ws + WS_H, ws + WS_WIN, MROWS, 1792, 512, c.G, c.bid);
    EpiInProj E{(bf16_t*)(ws + WS_U), (bf16_t*)(ws + WS_G), (bf16_t*)(ws + WS_Q), (bf16_t*)(ws + WS_K), (bf16_t*)(ws + WS_VT), (bf16_t*)(ws + WS_VTC), (const float*)(ws + WS_ROPE), (const float*)(ws + WS_SAH), (const float*)(ws + WS_SBW)};
    pg8::gemm_phase<EpiInProj, pg8::DenseOrder, false>(lds, 512, S, E);
}
__device__ __forceinline__ void ph_cin(const Args& args, LAS unsigned char* lds, const Ctx& c) {
    unsigned char* ws = args.ws;
    pg8::DenseOrder S; S.init(ws + WS_H, ws + WS_CIN, T, 2048, 512, c.G, c.bid);
    EpiGlu E{(bf16_t*)(ws + WS_GL), args.in[I_CMBIN], (const float*)(ws + WS_SAH), (const float*)(ws + WS_SBW) + 1792};
    pg8::gemm_phase<EpiGlu, pg8::DenseOrder, false>(lds, 512, S, E);
}
template <int l> __device__ __forceinline__ void ph_resid(const Args& args, LAS unsigned char* lds, const Ctx& c) {
    unsigned char* ws = args.ws;
    pg8::DenseOrder S; S.init(l == 0 ? ws + WS_Y1 : ws + WS_ZC, l == 0 ? ws + WS_WOUT : ws + WS_COUT, T, 1024, 512, c.G, c.bid);
    EpiResid E{(bf16_t*)(ws + WS_X), (const float*)(ws + WS_MOD) + (size_t)l * 17 * 6144 + 2 * 1024, l == 0 ? nullptr : args.in[I_CMBOUT], (float*)(ws + WS_SSQ)};
    pg8::gemm_phase<EpiResid, pg8::DenseOrder, false>(lds, 512, S, E);
}
template <int l> __device__ __forceinline__ void ph_moe1(const Args& args, LAS unsigned char* lds, const Ctx& c) {
    unsigned char* ws = args.ws;
    const int nbr = build_tables(args, lds, l);
    const char* bt0 = (const char*)(ws + WS_E13) + (size_t)l * NE1 * 512 * 1024;
    pg8::MoeOrder S; S.nunits = (nbr + 128) * 2; S.G = c.G; S.c = c.vcu; S.shift = 1; S.A = (const char*)(ws + WS_H); S.Bt = bt0;
    S.estride = (size_t)512 * 1024; S.btstep = (size_t)256 * 1024; S.atstep = 0; S.blk_e = (const LAS unsigned short*)(lds + LDS_BLKE_OFF); S.idx = (const LAS unsigned short*)(lds + LDS_IDX_OFF); S.gather = true;
    { const int* ST = (const int*)(ws + WS_SLOT_TOK); const float* SSA = (const float*)(ws + WS_SLOT_SA); const float* SB = (const float*)(ws + WS_SB13) + (size_t)l * NE1 * 512;
        LAS unsigned short* idx = (LAS unsigned short*)(lds + LDS_IDX_OFF); LAS float* sal = (LAS float*)(lds + LDS_SAL_OFF); LAS float* sbl = (LAS float*)(lds + LDS_SBL_OFF);
        int iv[11]; float fv[11];
#pragma unroll
        for (int i = 0; i < 11; ++i) { const int L = i * c.G + c.vcu; const bool ok = L < S.nunits; const int rb = ok ? (L >> 1) : 0, e = S.blk_e[rb]; iv[i] = 0; fv[i] = 0.f;
            if (c.tid < 256) { if (ok) { iv[i] = ST[(size_t)rb * 256 + c.tid]; fv[i] = SSA[(size_t)rb * 256 + c.tid]; } }
            else if (ok) fv[i] = SB[(size_t)e * 512 + (L & 1) * 256 + c.tid - 256]; }
#pragma unroll
        for (int i = 0; i < 11; ++i) { if (c.tid < 256) { idx[i * 256 + c.tid] = (unsigned short)iv[i]; sal[i * 256 + c.tid] = fv[i]; } else sbl[i * 256 + c.tid - 256] = fv[i]; } }
    __syncthreads();
    EpiMoe1 E{(unsigned char*)(ws + WS_HID), (const LAS float*)(lds + LDS_SAL_OFF), (const LAS float*)(lds + LDS_SBL_OFF)};
    pg8::gemm_phase<EpiMoe1, pg8::MoeOrder, true>(lds, 512, S, E);
}
template <int l> __device__ __forceinline__ void ph_moe2(const Args& args, LAS unsigned char* lds, const Ctx& c) {
    unsigned char* ws = args.ws;
    const int nbr = build_tables(args, lds, l);
    pg8::MoeOrder S; S.nunits = (nbr + 128) * 4; S.G = c.G; S.c = c.vcu; S.shift = 2; S.A = (const char*)(ws + WS_HID); S.Bt = (const char*)(ws + WS_E2) + (size_t)l * NE1 * 1024 * 256;
    S.estride = (size_t)1024 * 256; S.btstep = (size_t)256 * 256; S.atstep = (size_t)256 * 256; S.blk_e = (const LAS unsigned short*)(lds + LDS_BLKE_OFF); S.idx = nullptr; S.gather = false;
    { const float* SG = (const float*)(ws + WS_SLOT_GATE); LAS float* gl = (LAS float*)(lds + LDS_IDX_OFF);
        float gv[11]; const int hi = c.tid >> 8, t8 = c.tid & 255;
#pragma unroll
        for (int j = 0; j < 11; ++j) { const int L = (2 * j + hi) * c.G + c.vcu; gv[j] = (L < S.nunits) ? SG[(size_t)(L >> 2) * 256 + t8] : 0.f; }
#pragma unroll
        for (int j = 0; j < 11; ++j) gl[(2 * j + hi) * 256 + t8] = gv[j]; }
    __syncthreads();
    EpiMoe2 E{(unsigned char*)(ws + WS_Y), (const LAS float*)(lds + LDS_IDX_OFF)};
    pg8::gemm_phase<EpiMoe2, pg8::MoeOrder, false>(lds, 128, S, E);
}
#ifndef REPMASK
#define REPMASK 0
#endif
#ifndef PROBE_RT
#define PROBE_RT 0
#endif
#ifdef ONLY
#define PHON(id) ((id) == ONLY)
#else
#define PHON(id) true
#endif
#define RUN2(k, id, call, call2) do { if (PHON(id) && IN(k)) { if constexpr (((REPMASK >> (k)) & 1) != 0) { call2; __syncthreads(); } call; } } while (0)
#define RUN(k, id, call) do { if (PHON(id) && IN(k)) { call; if constexpr (((REPMASK >> (k)) & 1) != 0) { __syncthreads(); call; } } } while (0)
__global__ void __launch_bounds__(512, 2) fwd_kernel(Args args) {
    extern __shared__ __attribute__((aligned(16))) unsigned char lds_raw[];
    LAS unsigned char* lds = (LAS unsigned char*)lds_raw;
    Ctx c; c.tid = threadIdx.x; c.lane = c.tid & 63; c.wave = __builtin_amdgcn_readfirstlane(c.tid >> 6);
    c.G = gridDim.x; c.bid = blockIdx.x;
    c.vcu = (c.G % 8 == 0) ? (c.bid % 8) * (c.G / 8) + c.bid / 8 : c.bid;
    c.gw = c.bid * 8 + c.wave; c.NGW = c.G * 8;
    volatile LAS unsigned* MISC = (volatile LAS unsigned*)(lds + LDS_MISC_OFF);
    if (c.tid < 64) MISC[c.tid] = 0u;
    __syncthreads();
    unsigned* ctl = (unsigned*)(args.ws + WS_CTL);
    XcdBarrier bar = xcd_barrier_post(ctl + CW_BAR, MISC + 8);
    const int lo = args.ph_lo, hi = args.ph_hi;
#define IN(k) (lo <= (k) && (k) < hi)
#define SEAM(k, kn) do { if (IN(k) && IN(kn)) xcd_barrier(bar); } while (0)
    if (PHON(0) && IN(0)) {
#ifndef PROBE_P0
#define PROBE_P0 0
#endif
        for (int rep = 0; rep < ((PROBE_P0 == 1) ? 2 : 1); ++rep) { p0_mod(args, lds, c.tid, c.G, c.bid); p0_small(args, c.bid * 512 + c.tid, c.G * 512); __syncthreads(); }
        if (PROBE_P0 == 4) { p0_quant(args, lds, c.bid, c.G, args.ph_lo + 1); __syncthreads(); }
        for (int rep = 0; rep < ((PROBE_P0 == 2) ? 2 : 1); ++rep) { p0_quant(args, lds, c.bid, c.G, 0); __syncthreads(); }
        for (int rep = 0; rep < ((PROBE_P0 == 3) ? 2 : 1); ++rep) { p0_convert(args, lds, c.gw, c.NGW, c.wave, c.lane); __syncthreads(); }
    }
    SEAM(0, 1);
    if constexpr (((REPMASK >> 22) & 1) != 0) { for (int i = 0; i < 10; ++i) xcd_barrier(bar); }
    RUN(1, 1, p1_norm(args, c.gw, c.NGW, c.lane));
    SEAM(1, 2);
    RUN(2, 2, ph_inproj(args, lds, c));
    SEAM(2, 3);
    { int ob = c.bid; asm volatile("" : "+s"(ob));
      if constexpr (((REPMASK >> 3) & 1) != 0) { if (IN(3)) { attn_phase(args, lds, c.G, ob); __syncthreads(); } }
      if constexpr (((REPMASK >> 4) & 1) != 0) { if (IN(3)) { lru_phase<1>(args, lds, ob); __syncthreads(); } } }
    if (PHON(3) && IN(3)) { attn_phase(args, lds, c.G, c.vcu); lru_phase<1>(args, lds, c.vcu); }
    SEAM(3, 5);
    { int ob = c.bid; asm volatile("" : "+s"(ob));
      if constexpr (((REPMASK >> 5) & 1) != 0) { if (IN(5)) { lru_phase<2>(args, lds, ob); __syncthreads(); } } }
    if (PHON(5) && IN(5)) { lru_phase<2>(args, lds, c.vcu); }
    SEAM(5, 8);
    RUN(8, 8, ph_resid<0>(args, lds, c));
    SEAM(8, 9);
    RUN2(9, 9, router_phase(args, lds, 0, c.bid, c.G, 1), router_phase(args, lds, 0, c.bid, c.G, PROBE_RT));
    SEAM(9, 10);
    RUN(10, 10, slots_phase(args, lds, 0, c.bid));
    SEAM(10, 11);
    RUN(11, 11, ph_moe1<0>(args, lds, c));
    SEAM(11, 12);
    RUN(12, 12, ph_moe2<0>(args, lds, c));
    SEAM(12, 13);
    RUN(13, 13, combine_phase(args, 0, c.gw, c.NGW, c.lane));
    SEAM(13, 6);
    RUN(6, 6, ph_cin(args, lds, c));
    SEAM(6, 7);
    RUN(7, 7, conv_phase(args, lds, c.vcu, c.G));
    SEAM(7, 16);
    RUN(16, 8, ph_resid<1>(args, lds, c));
    SEAM(16, 17);
    RUN2(17, 9, router_phase(args, lds, 1, c.bid, c.G, 1), router_phase(args, lds, 1, c.bid, c.G, PROBE_RT));
    SEAM(17, 18);
    RUN(18, 10, slots_phase(args, lds, 1, c.bid));
    SEAM(18, 19);
    RUN(19, 11, ph_moe1<1>(args, lds, c));
    SEAM(19, 20);
    RUN(20, 12, ph_moe2<1>(args, lds, c));
    SEAM(20, 21);
    RUN(21, 13, combine_phase(args, 1, c.gw, c.NGW, c.lane));
#undef IN
#undef SEAM
}

constexpr int N_PHASES = 22;
extern "C" void kernel_launch(void* const* d_in, const int* in_sizes, int n_in, void* d_out, int out_size, void* d_ws, size_t ws_size, hipStream_t stream) {
    static int grid = 0;
    if (grid == 0) {
        if (n_in != 35 || in_sizes[0] != T * DM || out_size != T * DM || ws_size < WS_END) { fprintf(stderr, "kernel_launch: unexpected problem (n_in %d, in0 %d, out %d, ws %zu, need %zu); nothing launched\n", n_in, n_in > 0 ? in_sizes[0] : -1, out_size, ws_size, (size_t)WS_END); grid = -1; return; }
        int dev = 0, cus = 0, per_cu = 0;
        if (hipGetDevice(&dev) != hipSuccess || hipDeviceGetAttribute(&cus, hipDeviceAttributeMultiprocessorCount, dev) != hipSuccess) { grid = -1; return; }
        if (hipFuncSetAttribute((const void*)fwd_kernel, hipFuncAttributeMaxDynamicSharedMemorySize, LDS_BYTES) != hipSuccess) { fprintf(stderr, "kernel_launch: hipFuncSetAttribute failed\n"); grid = -1; return; }
        if (hipOccupancyMaxActiveBlocksPerMultiprocessor(&per_cu, (const void*)fwd_kernel, 512, LDS_BYTES) != hipSuccess || per_cu < 1) fprintf(stderr, "kernel_launch: occupancy query reports %d\n", per_cu);
        (void)hipGetLastError();
        grid = 256;
        if (cus < 256) { fprintf(stderr, "kernel_launch: %d CUs < 256: grid would not be resident; nothing launched\n", cus); grid = -1; return; }
    }
    if (grid < 0) return;
    if (hipMemsetAsync((char*)d_ws + WS_CTL, 0, CTL_ZERO_BYTES, stream) != hipSuccess) return;
    Args a{};
    for (int i = 0; i < 35; ++i) a.in[i] = (const float*)d_in[i];
    a.out = (float*)d_out; a.ws = (unsigned char*)d_ws; a.ph_lo = 0; a.ph_hi = N_PHASES;
    hipLaunchKernelGGL(fwd_kernel, dim3(grid), dim3(512), LDS_BYTES, stream, a);
}
```

```cpp
#include <hip/hip_runtime.h>
#include <cstdio>
#include <cstdint>

#define GAS __attribute__((address_space(1)))
#define LAS __attribute__((address_space(3)))
typedef unsigned short bf16_t;
typedef short bf16x8 __attribute__((ext_vector_type(8)));
typedef short s16x4 __attribute__((ext_vector_type(4)));
typedef float f32x2 __attribute__((ext_vector_type(2)));
typedef float f32x4 __attribute__((ext_vector_type(4)));
typedef float f32x16 __attribute__((ext_vector_type(16)));
typedef unsigned u32x2 __attribute__((ext_vector_type(2)));
typedef unsigned u32x4 __attribute__((ext_vector_type(4)));
typedef int i32x4 __attribute__((ext_vector_type(4)));
typedef int i32x8 __attribute__((ext_vector_type(8)));

constexpr int DM = 1024, NB_ = 16, SEQ = 2048, CTX = 256;
constexpr int T = NB_ * SEQ;
constexpr int TC = NB_ * CTX;
constexpr int MROWS = T + TC;
constexpr int NEXP = 256, NE1 = 257;
constexpr int MAXBLK = 1280 + 128;
constexpr int MAXSLOT = MAXBLK * 256;
constexpr float EPS = 1e-6f;
constexpr float LOG2E = 1.4426950408889634f;

constexpr size_t MiB = 1u << 20;
constexpr size_t WS_CTL = 0, CTL_ZERO_BYTES = 1 * MiB;
constexpr size_t WS_MOD = 1 * MiB;
constexpr size_t WS_ROPE = 2 * MiB;
constexpr size_t WS_GW = 2 * MiB + 65536;
constexpr size_t WS_AG = 3 * MiB;
constexpr size_t WS_CARRY = 8 * MiB;
constexpr size_t WS_SSQ = 10 * MiB;
constexpr size_t WS_TOK_E = 12 * MiB, WS_TOK_R = 13 * MiB, WS_TOK_W = 14 * MiB, WS_TOK_SLOT = 15 * MiB;
constexpr size_t WS_SLOT_TOK = 16 * MiB, WS_SLOT_GATE = 18 * MiB;
constexpr size_t WS_WIN = 20 * MiB, WS_WOUT = 24 * MiB, WS_CIN = 26 * MiB, WS_COUT = 30 * MiB, WS_RT = 32 * MiB;
constexpr size_t WS_E13 = 34 * MiB;
constexpr size_t WS_SB13 = 300 * MiB;
constexpr size_t WS_SA = 302 * MiB;
constexpr size_t WS_SLOT_SA = 303 * MiB;
constexpr size_t WS_SAH = 305 * MiB;
constexpr size_t WS_SBW = 306 * MiB;
constexpr size_t WS_E2 = 548 * MiB;
constexpr size_t WS_X = 806 * MiB;
constexpr size_t WS_H = 934 * MiB;
constexpr size_t WS_HID = 1006 * MiB;
constexpr size_t WS_Y = 1182 * MiB;
constexpr size_t WS_U = WS_Y, WS_G = WS_Y + 36 * MiB, WS_Q = WS_Y + 72 * MiB, WS_K = WS_Y + 108 * MiB, WS_VT = WS_Y + 117 * MiB, WS_VTC = WS_Y + 125 * MiB, WS_Y1 = WS_Y + 126 * MiB;
constexpr size_t WS_GL = WS_Y, WS_ZC = WS_Y + 64 * MiB;
constexpr size_t WS_END = 1886 * MiB;
static_assert(WS_E13 + (size_t)2 * NE1 * 512 * 1024 <= WS_SB13 && WS_SLOT_SA + (size_t)MAXSLOT * 4 <= WS_SAH && WS_SBW + 4096 * 4 <= WS_E2 && WS_E2 + (size_t)2 * NE1 * 1024 * 256 * 2 <= WS_X, "ws map");
static_assert(WS_H + (size_t)MROWS * 1024 * 2 <= WS_HID && WS_HID + (size_t)MAXSLOT * 256 * 2 <= WS_Y && WS_Y + (size_t)MAXSLOT * 1024 * 2 <= WS_END, "ws map");
constexpr int CW_BAR = 4096;
constexpr int CW_NBR = 16384;
constexpr int CW_CNT = 32768;

constexpr int LDS_IDX_OFF = 131072;
constexpr int LDS_SAL_OFF = LDS_IDX_OFF + 5632;
constexpr int LDS_SBL_OFF = LDS_SAL_OFF + 11264;
constexpr int LDS_BLKE_OFF = LDS_SBL_OFF + 11264;
constexpr int LDS_PB_OFF = LDS_BLKE_OFF + 3072;
constexpr int LDS_MISC_OFF = LDS_PB_OFF + 1280;
constexpr int LDS_BYTES = LDS_MISC_OFF + 256;
static_assert(LDS_BYTES <= 160 * 1024 && LDS_BYTES > 80 * 1024, "one workgroup per CU");

__device__ __forceinline__ unsigned cvt_pk_bf16(float lo, float hi) { unsigned r; asm volatile("v_cvt_pk_bf16_f32 %0, %1, %2" : "=v"(r) : "v"(lo), "v"(hi)); return r; }
__device__ __forceinline__ float bf_lo(unsigned u) { return __builtin_bit_cast(float, u << 16); }
__device__ __forceinline__ float bf_hi(unsigned u) { return __builtin_bit_cast(float, u & 0xffff0000u); }
__device__ __forceinline__ float sigm(float x) { return __builtin_amdgcn_rcpf(1.f + __expf(-x)); }
template <int CTRL, int RMASK, bool BC> __device__ __forceinline__ float dppf(float old, float src) {
    return __builtin_bit_cast(float, __builtin_amdgcn_update_dpp(__builtin_bit_cast(int, old), __builtin_bit_cast(int, src), CTRL, RMASK, 0xF, BC)); }
template <int CTRL, int RMASK, bool BC> __device__ __forceinline__ int dppi(int old, int src) { return __builtin_amdgcn_update_dpp(old, src, CTRL, RMASK, 0xF, BC); }
#define DPP_XOR1 0xB1
#define DPP_XOR2 0x4E
#define DPP_ROR4 0x124
#define DPP_ROR8 0x128
#define DPP_HMIRROR 0x141
#define DPP_BC15 0x142
#define DPP_BC31 0x143
__device__ __forceinline__ float rdlane_f(float v, int l) { return __builtin_bit_cast(float, __builtin_amdgcn_readlane(__builtin_bit_cast(int, v), l)); }
__device__ __forceinline__ float wave_sum(float v) {
    v += dppf<DPP_XOR1, 0xF, true>(0.f, v); v += dppf<DPP_XOR2, 0xF, true>(0.f, v); v += dppf<DPP_ROR4, 0xF, true>(0.f, v); v += dppf<DPP_ROR8, 0xF, true>(0.f, v);
    v += dppf<DPP_BC15, 0xA, false>(0.f, v); v += dppf<DPP_BC31, 0xC, false>(0.f, v);
    return rdlane_f(v, 63);
}
__device__ __forceinline__ float wave_max(float v) {
    v = fmaxf(v, dppf<DPP_XOR1, 0xF, true>(0.f, v)); v = fmaxf(v, dppf<DPP_XOR2, 0xF, true>(0.f, v)); v = fmaxf(v, dppf<DPP_ROR4, 0xF, true>(0.f, v)); v = fmaxf(v, dppf<DPP_ROR8, 0xF, true>(0.f, v));
    v = fmaxf(v, dppf<DPP_BC15, 0xA, false>(v, v)); v = fmaxf(v, dppf<DPP_BC31, 0xC, false>(v, v));
    return rdlane_f(v, 63);
}
__device__ __forceinline__ u32x2 pack8_fp8(const f32x4 a, const f32x4 b) { int w0 = 0, w1 = 0;
    w0 = __builtin_amdgcn_cvt_pk_fp8_f32(a[0], a[1], w0, false); w0 = __builtin_amdgcn_cvt_pk_fp8_f32(a[2], a[3], w0, true);
    w1 = __builtin_amdgcn_cvt_pk_fp8_f32(b[0], b[1], w1, false); w1 = __builtin_amdgcn_cvt_pk_fp8_f32(b[2], b[3], w1, true); return (u32x2){(unsigned)w0, (unsigned)w1}; }
#define BAR_LDS() asm volatile("s_waitcnt lgkmcnt(0)\n\ts_barrier" ::: "memory")
#define LDS_WAIT() asm volatile("s_waitcnt lgkmcnt(0)" ::: "memory")

#define XB_TMO      128
#define XB_XCNT(j)  (256  + 64 * (j))
#define XB_XSUB(j)  (1280 + 64 * (j))
#define XB_XGEN(j)  (2304 + 64 * (j))
#define XB_TOP      3328
#define XB_TOPGEN   3392
#define XCD_BAR_WORDS 3456
#define XB_SPIN_CAP (1u << 18)
__device__ __forceinline__ unsigned xb_ld(unsigned* p)              { return __hip_atomic_load(p, __ATOMIC_RELAXED, __HIP_MEMORY_SCOPE_AGENT); }
__device__ __forceinline__ unsigned xb_add(unsigned* p, unsigned v) { return __hip_atomic_fetch_add(p, v, __ATOMIC_RELAXED, __HIP_MEMORY_SCOPE_AGENT); }
__device__ __forceinline__ unsigned xb_xcc_id() { return (unsigned)__builtin_amdgcn_s_getreg((3 << 11) | 20) & 0xFu; }
#define XB_SPIN(cond, bar) do { unsigned _sp = 0; while (cond) { __builtin_amdgcn_s_sleep(1); \
    if ((++_sp & 255u) == 0u) { if (xb_ld(&(bar)[XB_TMO])) break; if (_sp > XB_SPIN_CAP) { atomicAdd(&(bar)[XB_TMO], 1u); break; } } } } while (0)
struct XcdBarrier { unsigned* bar; unsigned x; volatile LAS unsigned* st; };
__device__ __forceinline__ XcdBarrier xcd_barrier_post(unsigned* bar, volatile LAS unsigned* st) {
    XcdBarrier b; b.bar = bar; b.x = xb_xcc_id(); b.st = st;
    if (threadIdx.x == 0) (void)xb_add(&bar[XB_XCNT(b.x)], 1u);
    return b;
}
__device__ __forceinline__ void xcd_barrier_complete(unsigned* bar, unsigned x, unsigned& nloc, unsigned& nx) {
    const unsigned G = gridDim.x * gridDim.y * gridDim.z;
    unsigned sum, cnt, mine, sp = 0u;
    for (;;) {
        sum = 0u; cnt = 0u; mine = 0u;
#pragma unroll
        for (unsigned j = 0; j < 16; ++j) { const unsigned c = xb_ld(&bar[XB_XCNT(j)]); sum += c; cnt += (c > 0u) ? 1u : 0u; mine = (j == x) ? c : mine; }
        if (sum == G) break;
        __builtin_amdgcn_s_sleep(1);
        if ((++sp & 255u) == 0u) { if (xb_ld(&bar[XB_TMO])) break; if (sp > XB_SPIN_CAP) { atomicAdd(&bar[XB_TMO], 1u); break; } }
    }
    nloc = mine > 0u ? mine : 1u; nx = cnt > 0u ? cnt : 1u;
}
__device__ __forceinline__ void xcd_barrier(const XcdBarrier& b) {
    asm volatile("s_waitcnt vmcnt(0)" ::: "memory");
    __syncthreads();
    if (threadIdx.x == 0) {
        unsigned* bar = b.bar;
        __builtin_amdgcn_s_waitcnt(0);
        unsigned nloc = b.st[0], nx = b.st[1];
        if (nloc == 0u) { xcd_barrier_complete(bar, b.x, nloc, nx); b.st[0] = nloc; b.st[1] = nx; }
        const unsigned old = xb_add(&bar[XB_XSUB(b.x)], 1u);
        const unsigned gen = old / nloc;
        if (old + 1u == (gen + 1u) * nloc) {
            __builtin_amdgcn_fence(__ATOMIC_RELEASE, "agent");
            asm volatile("s_waitcnt vmcnt(0)" ::: "memory");
            const unsigned og = xb_add(&bar[XB_TOP], 1u);
            const unsigned tg = og / nx;
            if (og + 1u == (tg + 1u) * nx) xb_add(&bar[XB_TOPGEN], 1u);
            else XB_SPIN(xb_ld(&bar[XB_TOPGEN]) == tg, bar);
            __builtin_amdgcn_fence(__ATOMIC_ACQUIRE, "agent");
            xb_add(&bar[XB_XGEN(b.x)], 1u);
            asm volatile("s_waitcnt vmcnt(0)" ::: "memory");
        } else {
            XB_SPIN(xb_ld(&bar[XB_XGEN(b.x)]) == gen, bar);
            __builtin_amdgcn_fence(__ATOMIC_ACQUIRE, "agent");
            asm volatile("s_waitcnt vmcnt(0)" ::: "memory");
        }
    }
    __syncthreads();
}

namespace pg8 {
constexpr int BM = 256, BK = 64, HALF = 128, HTB = HALF * BK * 2, NXCD = 8, WGM = 8;
__host__ __device__ __forceinline__ int lds_byte(int r, int c) { const int st = (r >> 4) * 2 + (c >> 5), rr = r & 15, cc = c & 31, ob = rr * 64 + cc * 2; return st * 1024 + (ob ^ (((ob >> 9) & 1) << 5)); }
__host__ __device__ __forceinline__ void stage_rc(int b, int& R, int& C) { const int st = b / 1024, sb = b % 1024, swz = sb ^ (((sb >> 9) & 1) << 5); R = (st >> 1) * 16 + swz / 64; C = (st & 1) * 32 + (swz % 64) / 2; }
__host__ __device__ __forceinline__ int perm32(int rho) { const int n = rho >> 4, i = rho & 15; return 8 * (i >> 2) + 4 * n + (i & 3); }

struct Unit { int pm, pn, lrb, ui; const char* A; const char* B; };

struct DenseOrder {
    int nM, nN, nwg, G, c; const char* A; const char* Bt; size_t tstep;
    __device__ void init(const void* A_, const void* Bt_, int M, int N, int K, int G_, int c_) { nM = M / BM; nN = N / BM; nwg = nM * nN; G = G_; c = c_; A = (const char*)A_; Bt = (const char*)Bt_; tstep = (size_t)BM * K * 2; }
    __device__ bool next(int i, Unit& u) const {
        const long L = (long)i * G + c; if (L >= nwg) return false;
        int wgid = (int)L; { const int q = nwg / NXCD, r = nwg % NXCD, xcd = wgid % NXCD, off = wgid / NXCD; wgid = (xcd < r ? xcd * (q + 1) : r * (q + 1) + (xcd - r) * q) + off; }
        const int nig = WGM * nN, gid = wgid / nig, fm = gid * WGM, gsz = (nM - fm) < WGM ? (nM - fm) : WGM;
        u.pm = fm + ((wgid % nig) % gsz); u.pn = (wgid % nig) / gsz; u.lrb = 0; u.ui = i; u.A = A + (size_t)u.pm * tstep; u.B = Bt + (size_t)u.pn * tstep; return true;
    }
    __device__ const LAS unsigned short* rows(int) const { return nullptr; }
};
struct MoeOrder {
    int nunits, G, c, shift; const char* A; const char* Bt; size_t estride, btstep, atstep; const LAS unsigned short* blk_e; const LAS unsigned short* idx; bool gather;
    __device__ bool next(int i, Unit& u) const {
        const int L = i * G + c; if (L >= nunits) return false;
        const int rb = L >> shift, pn = L & ((1 << shift) - 1);
        const int e = __builtin_amdgcn_readfirstlane((int)blk_e[rb]);
        u.pm = rb; u.pn = pn; u.lrb = i; u.ui = i; u.A = gather ? A : A + (size_t)rb * atstep; u.B = Bt + (size_t)e * estride + (size_t)pn * btstep; return true;
    }
    __device__ const LAS unsigned short* rows(int i) const { return idx + i * 256; }
};

template <class Epi, class Sched, bool GATHER>
__device__ __forceinline__ void gemm_phase(LAS unsigned char* lds, const int K, const Sched& S, const Epi& E) {
    const int tid = threadIdx.x, wid = __builtin_amdgcn_readfirstlane(tid >> 6), lane = tid & 63, wr = wid >> 2, wc = wid & 3, fr = lane & 15, fq = lane >> 4;
    const int nt = K / BK;
    int RA[2], CA[2]; unsigned voffB[2];
#pragma unroll
    for (int i = 0; i < 2; ++i) { int R, C; stage_rc(tid * 16 + i * 8192, R, C); const int Rb = Epi::PERM ? ((R & ~31) + perm32(R & 31)) : R;
        RA[i] = R; CA[i] = C; voffB[i] = (unsigned)(Rb * K + C) * 2u; }
    unsigned vA0[2], vA1[2];
    const size_t kstep = (size_t)(BK * 2);
    const size_t hstep = (size_t)HALF * K * 2;
    const unsigned ldsw = (unsigned)wid * 1024u;
    const int aoff = lds_byte(wr * 64 + fr, fq * 8), boff = lds_byte(wc * 32 + fr, fq * 8);
#define PG8_SA(b, h) (((b) * 2 + (h)) * HTB)
#define PG8_SB(b, h) ((4 + (b) * 2 + (h)) * HTB)
#define PG8_STAGE(bufoff, gbase, voff) do { _Pragma("unroll") for (int _i = 0; _i < 2; ++_i) \
        __builtin_amdgcn_global_load_lds((const unsigned*)((const char*)(gbase) + (voff)[_i]), (LAS unsigned*)(lds + (bufoff) + ldsw + _i * 8192), 16, 0, 0); } while (0)
#define PG8_CAT8(p0_, p1_) __builtin_shufflevector(*(const LAS i32x4*)(p0_), *(const LAS i32x4*)(p1_), 0, 1, 2, 3, 4, 5, 6, 7)
#define PG8_LDA(dst, b, h) do { if constexpr (Epi::F8) { _Pragma("unroll") for (int m = 0; m < 4; ++m) dst##8[m] = PG8_CAT8(lds + PG8_SA(b, h) + aoff + m * 2048, lds + PG8_SA(b, h) + aoff + m * 2048 + 1024); } \
        else { _Pragma("unroll") for (int m = 0; m < 4; ++m) _Pragma("unroll") for (int k = 0; k < 2; ++k) dst[m][k] = *(const LAS bf16x8*)(lds + PG8_SA(b, h) + aoff + m * 2048 + k * 1024); } } while (0)
#define PG8_LDB(dst, b, h) do { if constexpr (Epi::F8) { _Pragma("unroll") for (int n = 0; n < 2; ++n) dst##8[n] = PG8_CAT8(lds + PG8_SB(b, h) + boff + n * 2048, lds + PG8_SB(b, h) + boff + n * 2048 + 1024); } \
        else { _Pragma("unroll") for (int n = 0; n < 2; ++n) _Pragma("unroll") for (int k = 0; k < 2; ++k) dst[n][k] = *(const LAS bf16x8*)(lds + PG8_SB(b, h) + boff + n * 2048 + k * 1024); } } while (0)
#define PG8_MMA(ai, bj, At, Bt) do { __builtin_amdgcn_s_setprio(1); \
        if constexpr (Epi::F8) { _Pragma("unroll") for (int m = 0; m < 4; ++m) _Pragma("unroll") for (int n = 0; n < 2; ++n) \
            asm volatile("v_mfma_scale_f32_16x16x128_f8f6f4 %0, %1, %2, %0, %3, %4 op_sel_hi:[0,0,0]" : "+v"(acc[ai][bj][m][n]) : "v"(Bt##8[n]), "v"(At##8[m]), "v"(sclw), "v"(scla)); } \
        else { _Pragma("unroll") for (int m = 0; m < 4; ++m) _Pragma("unroll") for (int n = 0; n < 2; ++n) _Pragma("unroll") for (int k = 0; k < 2; ++k) \
        { if constexpr (Epi::I8) acc[ai][bj][m][n] = __builtin_bit_cast(f32x4, __builtin_amdgcn_mfma_i32_16x16x64_i8(__builtin_bit_cast(i32x4, Bt[n][k]), __builtin_bit_cast(i32x4, At[m][k]), __builtin_bit_cast(i32x4, acc[ai][bj][m][n]), 0, 0, 0)); \
          else acc[ai][bj][m][n] = __builtin_amdgcn_mfma_f32_16x16x32_bf16(Bt[n][k], At[m][k], acc[ai][bj][m][n], 0, 0, 0); } } __builtin_amdgcn_s_setprio(0); } while (0)
#define PG8_WAIT_V(n) asm volatile("s_waitcnt vmcnt(" #n ")" ::: "memory")
#define PG8_WAIT_L(n) asm volatile("s_waitcnt lgkmcnt(" #n ")" ::: "memory")
#define PG8_BAR __builtin_amdgcn_s_barrier()
#define PG8_SCHED __builtin_amdgcn_sched_barrier(0)
#define PG8_SETA(v0, v1, ui_) do { if constexpr (GATHER) { const LAS unsigned short* _rw = S.rows(ui_); _Pragma("unroll") for (int _i = 0; _i < 2; ++_i) { \
            v0[_i] = (unsigned)((int)_rw[RA[_i]] * K + CA[_i]) * 2u; v1[_i] = (unsigned)((int)_rw[HALF + RA[_i]] * K + CA[_i]) * 2u; } } \
        else { _Pragma("unroll") for (int _i = 0; _i < 2; ++_i) { v0[_i] = (unsigned)(RA[_i] * K + CA[_i]) * 2u; v1[_i] = v0[_i]; } } } while (0)
#define PG8_A1(p) (GATHER ? (p) : (p) + hstep)
    Unit cur, nxt; int ui = 0;
    if (!S.next(0, cur)) return;
    f32x4 acc[2][2][4][2];
#pragma unroll
    for (int a = 0; a < 2; ++a)
#pragma unroll
        for (int b = 0; b < 2; ++b)
#pragma unroll
            for (int m = 0; m < 4; ++m)
#pragma unroll
                for (int n = 0; n < 2; ++n) acc[a][b][m][n] = (f32x4){0.f, 0.f, 0.f, 0.f};
    bf16x8 At[4][2], B0[2][2], B1[2][2];
    i32x8 At8[4], B08[2], B18[2];
    int sclw = 0x7b7b7b7b, scla = 0x7f7f7f7f;
    asm volatile("" : "+v"(sclw), "+v"(scla));
    const char* cA = cur.A; const char* cB = cur.B;
    PG8_SETA(vA0, vA1, 0);
    PG8_STAGE(PG8_SB(0, 0), cB, voffB); PG8_STAGE(PG8_SB(0, 1), cB + hstep, voffB); PG8_STAGE(PG8_SA(0, 0), cA, vA0); PG8_STAGE(PG8_SA(0, 1), PG8_A1(cA), vA1);
    if (wr == 1) PG8_BAR;
    PG8_WAIT_V(2); PG8_BAR;
    PG8_STAGE(PG8_SB(1, 0), cB + kstep, voffB); PG8_STAGE(PG8_SA(1, 0), cA + kstep, vA0); PG8_STAGE(PG8_SB(1, 1), cB + hstep + kstep, voffB);
    PG8_WAIT_V(6); PG8_BAR;
    for (;;) {
        const bool has_next = S.next(ui + 1, nxt);
        const char* nA = has_next ? nxt.A : cA; const char* nB = has_next ? nxt.B : cB;
#pragma unroll 1
        for (int t = 0; t < nt; t += 2) {
            const bool last = (t == nt - 2);
            const char* a1 = cA + (size_t)(t + 1) * kstep;
            const char* a2 = last ? nA : cA + (size_t)(t + 2) * kstep; const char* b2 = last ? nB : cB + (size_t)(t + 2) * kstep;
            const char* a3 = a2 + kstep; const char* b3 = b2 + kstep;
            PG8_LDB(B0, 0, 0); PG8_LDB(B1, 0, 1); PG8_SCHED; PG8_LDA(At, 0, 0); PG8_STAGE(PG8_SA(1, 1), PG8_A1(a1), vA1);
            if constexpr (GATHER) { if (last && has_next) PG8_SETA(vA0, vA1, ui + 1); }
            PG8_WAIT_V(8); PG8_WAIT_L(0); PG8_BAR; PG8_MMA(0, 0, At, B0); PG8_MMA(0, 1, At, B1); PG8_BAR; PG8_SCHED;
            PG8_LDA(At, 0, 1); PG8_STAGE(PG8_SB(0, 0), b2, voffB); PG8_STAGE(PG8_SB(0, 1), b2 + hstep, voffB); PG8_STAGE(PG8_SA(0, 0), a2, vA0);
            PG8_WAIT_V(8); PG8_WAIT_L(0); PG8_BAR; PG8_MMA(1, 0, At, B0); PG8_MMA(1, 1, At, B1); PG8_BAR; PG8_SCHED;
            PG8_LDB(B0, 1, 0); PG8_LDB(B1, 1, 1); PG8_SCHED; PG8_LDA(At, 1, 0); PG8_STAGE(PG8_SA(0, 1), PG8_A1(a2), vA1);
            PG8_WAIT_V(8); PG8_WAIT_L(0); PG8_BAR; PG8_MMA(0, 0, At, B0); PG8_MMA(0, 1, At, B1); PG8_BAR; PG8_SCHED;
            PG8_LDA(At, 1, 1); PG8_STAGE(PG8_SB(1, 0), b3, voffB); PG8_STAGE(PG8_SB(1, 1), b3 + hstep, voffB); PG8_STAGE(PG8_SA(1, 0), a3, vA0);
            PG8_WAIT_V(8); PG8_WAIT_L(0); PG8_BAR; PG8_MMA(1, 0, At, B0); PG8_MMA(1, 1, At, B1); PG8_BAR; PG8_SCHED;
        }
        if (wr == 0) PG8_BAR;
        if constexpr (Epi::F8) asm volatile("s_nop 15\n\ts_nop 15" ::: "memory");
        E(acc, cur, wr, wc, fr, fq);
        if (!has_next) break;
#pragma unroll
        for (int a = 0; a < 2; ++a)
#pragma unroll
            for (int b = 0; b < 2; ++b)
#pragma unroll
                for (int m = 0; m < 4; ++m)
#pragma unroll
                    for (int n = 0; n < 2; ++n) acc[a][b][m][n] = (f32x4){0.f, 0.f, 0.f, 0.f};
        cur = nxt; cA = nA; cB = nB; ++ui;
        if (wr == 1) PG8_BAR;
    }
    PG8_WAIT_V(0);
    PG8_BAR;
#undef PG8_SA
#undef PG8_SB
#undef PG8_STAGE
#undef PG8_LDA
#undef PG8_CAT8
#undef PG8_LDB
#undef PG8_MMA
#undef PG8_WAIT_V
#undef PG8_WAIT_L
#undef PG8_BAR
#undef PG8_SCHED
#undef PG8_SETA
#undef PG8_A1
}
}

using pg8::Unit;
typedef f32x4 Acc[2][2][4][2];
__device__ __forceinline__ u32x4 pack8(const f32x4 a, const f32x4 b) { u32x4 w; w.x = cvt_pk_bf16(a[0], a[1]); w.y = cvt_pk_bf16(a[2], a[3]); w.z = cvt_pk_bf16(b[0], b[1]); w.w = cvt_pk_bf16(b[2], b[3]); return w; }
#define ST16(base, off, v) (*(u32x4*)((char*)(base) + (unsigned)(off)) = (v))
#define LDF4(base, off) (*(const f32x4*)((const char*)(base) + (unsigned)(off)))

__device__ __forceinline__ f32x4 i8f(const f32x4 a, const float ra, const f32x4 sb) { const i32x4 v = __builtin_bit_cast(i32x4, a); return (f32x4){(float)v[0], (float)v[1], (float)v[2], (float)v[3]} * (sb * ra); }
struct EpiInProj {
    static constexpr bool PERM = true, I8 = true, F8 = false;
    bf16_t *U, *G, *Q, *Kb, *VT, *VTC; const float* rope; const float* sa; const float* sb;
    __device__ __forceinline__ void operator()(const Acc& acc, const Unit& u, int wr, int wc, int fr, int fq) const {
        const int pn = u.pn, rowb = u.pm * 256 + wr * 64 + fr, c8 = wc * 32 + 8 * fq;
        if (pn >= 2 && pn < 6 && u.pm >= T / 256) return;
        const unsigned so = (unsigned)(pn * 256 + c8) * 4u;
        const f32x4 s00 = LDF4(sb, so), s01 = LDF4(sb, so + 16u), s10 = LDF4(sb, so + 512u), s11 = LDF4(sb, so + 528u);
        float rav[2][4];
#pragma unroll
        for (int ai = 0; ai < 2; ++ai)
#pragma unroll
            for (int m = 0; m < 4; ++m) rav[ai][m] = *(const float*)((const char*)sa + (unsigned)(rowb + ai * 128 + m * 16) * 4u);
        if (pn < 4) {
            bf16_t* base = (pn < 2 ? U : G);
            const unsigned o0 = (unsigned)(rowb * 512 + (pn & 1) * 256 + c8) * 2u;
            __builtin_amdgcn_sched_barrier(0);
#pragma unroll
            for (int ai = 0; ai < 2; ++ai)
#pragma unroll
                for (int m = 0; m < 4; ++m) { const float ra = rav[ai][m];
                    ST16(base, o0 + (unsigned)((ai * 128 + m * 16) * 512) * 2u, pack8(i8f(acc[ai][0][m][0], ra, s00), i8f(acc[ai][0][m][1], ra, s01)));
                    ST16(base, o0 + (unsigned)((ai * 128 + m * 16) * 512 + 128) * 2u, pack8(i8f(acc[ai][1][m][0], ra, s10), i8f(acc[ai][1][m][1], ra, s11))); }
        } else if (pn < 6) {
            const float QS = 0.125f * LOG2E;
            const unsigned o0 = (unsigned)(rowb * 512 + (pn - 4) * 256 + c8) * 2u;
#pragma unroll
            for (int ai = 0; ai < 2; ++ai) { f32x4 r0[4], r1[4];
#pragma unroll
                for (int m = 0; m < 4; ++m) { const int row = rowb + ai * 128 + m * 16, sq = row & (SEQ - 1), pos = (wc & 1) ? (sq & 63) : (sq >> 6);
                    const unsigned ro = (unsigned)((pos * 16 + 4 * fq) * 8); r0[m] = LDF4(rope, ro); r1[m] = LDF4(rope, ro + 16u); }
                __builtin_amdgcn_sched_barrier(0);
#pragma unroll
                for (int m = 0; m < 4; ++m) { const float ra = rav[ai][m] * QS;
                    const f32x4 cs = {r0[m][0], r0[m][2], r1[m][0], r1[m][2]}, sn = {r0[m][1], r0[m][3], r1[m][1], r1[m][3]};
#pragma unroll
                    for (int bj = 0; bj < 2; ++bj) { const f32x4 x1 = i8f(acc[ai][bj][m][0], ra, bj ? s10 : s00), x2 = i8f(acc[ai][bj][m][1], ra, bj ? s11 : s01);
                        ST16(Q, o0 + (unsigned)((ai * 128 + m * 16) * 512 + bj * 128) * 2u, pack8(x1 * cs - x2 * sn, x2 * cs + x1 * sn)); } }
                __builtin_amdgcn_sched_barrier(0); }
        } else {
#pragma unroll
            for (int ai = 0; ai < 2; ++ai) { f32x4 r0[4], r1[4];
#pragma unroll
                for (int m = 0; m < 4; ++m) { const int row = rowb + ai * 128 + m * 16, sq = row & (SEQ - 1), pos = (wc & 1) ? (sq & 63) : (sq >> 6);
                    const unsigned ro = (unsigned)((pos * 16 + 4 * fq) * 8); r0[m] = LDF4(rope, ro); r1[m] = LDF4(rope, ro + 16u); }
                __builtin_amdgcn_sched_barrier(0);
#pragma unroll
                for (int m = 0; m < 4; ++m) { const int row = rowb + ai * 128 + m * 16; const float ra = rav[ai][m];
                    f32x4 x1 = i8f(acc[ai][0][m][0], ra, s00), x2 = i8f(acc[ai][0][m][1], ra, s01);
                    if (row < T) { const f32x4 cs = {r0[m][0], r0[m][2], r1[m][0], r1[m][2]}, sn = {r0[m][1], r0[m][3], r1[m][1], r1[m][3]};
                        const f32x4 o1 = x1 * cs - x2 * sn, o2 = x2 * cs + x1 * sn; x1 = o1; x2 = o2; }
                    ST16(Kb, (unsigned)(row * 128 + c8) * 2u, pack8(x1, x2));
                    ST16(VT, (unsigned)(row * 128 + c8) * 2u, pack8(i8f(acc[ai][1][m][0], ra, s10), i8f(acc[ai][1][m][1], ra, s11))); }
                __builtin_amdgcn_sched_barrier(0); }
        }
    }
};
struct EpiResid {
    static constexpr bool PERM = true, I8 = false, F8 = true;
    bf16_t* xs; const float* gate; const float* bias; float* ssq;
    __device__ __forceinline__ void operator()(const Acc& acc, const Unit& u, int wr, int wc, int fr, int fq) const {
        const int rowb = u.pm * 256 + wr * 64 + fr, col0 = u.pn * 256 + wc * 32 + 8 * fq;
        const unsigned go = (unsigned)(((u.pm * 256) >> 11) * 6144 + col0) * 4u;
        f32x4 g[2][2], bb[2][2];
#pragma unroll
        for (int bj = 0; bj < 2; ++bj)
#pragma unroll
            for (int n = 0; n < 2; ++n) { g[bj][n] = LDF4(gate, go + (unsigned)(bj * 128 + 4 * n) * 4u); bb[bj][n] = bias ? LDF4(bias, (unsigned)(col0 + bj * 128 + 4 * n) * 4u) : (f32x4){0.f, 0.f, 0.f, 0.f}; }
#pragma unroll
        for (int ai = 0; ai < 2; ++ai) { u32x4 xw[4][2];
#pragma unroll
            for (int m = 0; m < 4; ++m)
#pragma unroll
                for (int bj = 0; bj < 2; ++bj) xw[m][bj] = *(const u32x4*)((const char*)xs + ((unsigned)((rowb + ai * 128 + m * 16) * DM + col0) + (unsigned)(bj * 128)) * 2u);
            __builtin_amdgcn_sched_barrier(0);
#pragma unroll
            for (int m = 0; m < 4; ++m) { const int row = rowb + ai * 128 + m * 16; const unsigned xo = (unsigned)(row * DM + col0);
                float ss = 0.f;
#pragma unroll
                for (int bj = 0; bj < 2; ++bj) { const u32x4 w = xw[m][bj];
                    const f32x4 x0 = {bf_lo(w.x), bf_hi(w.x), bf_lo(w.y), bf_hi(w.y)}, x1 = {bf_lo(w.z), bf_hi(w.z), bf_lo(w.w), bf_hi(w.w)};
                    const f32x4 y0 = x0 + g[bj][0] * (acc[ai][bj][m][0] + bb[bj][0]), y1 = x1 + g[bj][1] * (acc[ai][bj][m][1] + bb[bj][1]);
                    ST16(xs, (xo + (unsigned)(bj * 128)) * 2u, pack8(y0, y1));
                    ss += ((y0[0] * y0[0] + y0[1] * y0[1]) + (y0[2] * y0[2] + y0[3] * y0[3])) + ((y1[0] * y1[0] + y1[1] * y1[1]) + (y1[2] * y1[2] + y1[3] * y1[3])); }
                ss += __shfl_xor(ss, 16); ss += __shfl_xor(ss, 32);
                if (fq == 0) *(float*)((char*)ssq + (unsigned)(row * 16 + u.pn * 4 + wc) * 4u) = ss; }
            __builtin_amdgcn_sched_barrier(0); }
    }
};
struct EpiMoe1 {
    static constexpr bool PERM = true, I8 = true, F8 = false;
    unsigned char* HID; const LAS float* sal; const LAS float* sbl;
    __device__ __forceinline__ void operator()(const Acc& acc, const Unit& u, int wr, int wc, int fr, int fq) const {
        const int rowb = u.pm * 256 + wr * 64 + fr;
        const unsigned o0 = (unsigned)(rowb * 256 + u.pn * 128 + wc * 32 + 16 * (fq & 1)) + ((fq >> 1) ? 16u * 256u : 0u);
        const LAS float* sp = sbl + u.ui * 256 + wc * 32 + 8 * fq;
        const f32x4 s10 = *(const LAS f32x4*)sp, s11 = *(const LAS f32x4*)(sp + 4), s30 = *(const LAS f32x4*)(sp + 128), s31 = *(const LAS f32x4*)(sp + 132);
        const LAS float* rp = sal + u.lrb * 256 + wr * 64 + fr;
#pragma unroll
        for (int ai = 0; ai < 2; ++ai)
#pragma unroll
            for (int mp = 0; mp < 2; ++mp) { const float ra0 = rp[ai * 128 + mp * 32], ra1 = rp[ai * 128 + mp * 32 + 16];
                if (__builtin_amdgcn_ballot_w64(ra0 != 0.f || ra1 != 0.f) == 0) continue;
                u32x2 P[2];
#pragma unroll
                for (int h = 0; h < 2; ++h) { const int m = 2 * mp + h; const float ra = h ? ra1 : ra0; f32x4 h0, h1;
                    const i32x4 a0i = __builtin_bit_cast(i32x4, acc[ai][0][m][0]), a1i = __builtin_bit_cast(i32x4, acc[ai][0][m][1]), b0i = __builtin_bit_cast(i32x4, acc[ai][1][m][0]), b1i = __builtin_bit_cast(i32x4, acc[ai][1][m][1]);
#pragma unroll
                    for (int j = 0; j < 4; ++j) { const float a0 = (float)a0i[j] * (ra * s10[j]), a1 = (float)a1i[j] * (ra * s11[j]), b0 = (float)b0i[j] * (ra * s30[j]), b1 = (float)b1i[j] * (ra * s31[j]);
                        h0[j] = a0 * sigm(a0) * b0; h1[j] = a1 * sigm(a1) * b1; }
                    P[h] = pack8_fp8(h0, h1); }
                const u32x2 sx = __builtin_amdgcn_permlane32_swap(P[0].x, P[1].x, false, false), sy = __builtin_amdgcn_permlane32_swap(P[0].y, P[1].y, false, false);
                *(u32x4*)((char*)HID + (o0 + (unsigned)((ai * 128 + mp * 32) * 256))) = (u32x4){sx.x, sy.x, sx.y, sy.y}; }
    }
};
struct EpiMoe2 {
    static constexpr bool PERM = true, I8 = false, F8 = true;
    unsigned char* Y; const LAS float* gl;
    __device__ __forceinline__ void operator()(const Acc& acc, const Unit& u, int wr, int wc, int fr, int fq) const {
        const int rowb = u.pm * 256 + wr * 64 + fr; const unsigned o0 = (unsigned)(rowb * DM + u.pn * 256 + wc * 64 + 16 * fq);
        const LAS float* gp = gl + u.lrb * 256 + wr * 64 + fr;
#pragma unroll
        for (int ai = 0; ai < 2; ++ai)
#pragma unroll
            for (int m = 0; m < 4; ++m) { const float g = 16.f * gp[ai * 128 + m * 16];
                if (__builtin_amdgcn_ballot_w64(g != 0.f) == 0) continue;
                const u32x2 lo = pack8_fp8(acc[ai][0][m][0] * g, acc[ai][0][m][1] * g), hi = pack8_fp8(acc[ai][1][m][0] * g, acc[ai][1][m][1] * g);
                *(u32x4*)((char*)Y + (o0 + (unsigned)((ai * 128 + m * 16) * DM))) = (u32x4){lo.x, lo.y, hi.x, hi.y}; }
    }
};
struct EpiGlu {
    static constexpr bool PERM = true, I8 = true, F8 = false;
    bf16_t* GL; const float* bias; const float* sa; const float* sb;
    __device__ __forceinline__ void operator()(const Acc& acc, const Unit& u, int wr, int wc, int fr, int fq) const {
        const int col = u.pn * 128 + wc * 32 + 8 * fq, rowb = u.pm * 256 + wr * 64 + fr; const unsigned o0 = (unsigned)(rowb * DM + col) * 2u, bo = (unsigned)col * 4u;
        const unsigned so = (unsigned)(u.pn * 256 + wc * 32 + 8 * fq) * 4u;
        const f32x4 s00 = LDF4(sb, so), s01 = LDF4(sb, so + 16u), s10 = LDF4(sb, so + 512u), s11 = LDF4(sb, so + 528u);
        const f32x4 bv0 = LDF4(bias, bo), bv1 = LDF4(bias, bo + 16u), bg0 = LDF4(bias, bo + 4096u), bg1 = LDF4(bias, bo + 4112u);
        float rav[2][4];
#pragma unroll
        for (int ai = 0; ai < 2; ++ai)
#pragma unroll
            for (int m = 0; m < 4; ++m) rav[ai][m] = *(const float*)((const char*)sa + (unsigned)(rowb + ai * 128 + m * 16) * 4u);
        __builtin_amdgcn_sched_barrier(0);
#pragma unroll
        for (int ai = 0; ai < 2; ++ai)
#pragma unroll
            for (int m = 0; m < 4; ++m) { f32x4 o0v, o1v; const float ra = rav[ai][m];
                const f32x4 v0 = i8f(acc[ai][0][m][0], ra, s00) + bv0, v1 = i8f(acc[ai][0][m][1], ra, s01) + bv1, g0 = i8f(acc[ai][1][m][0], ra, s10) + bg0, g1 = i8f(acc[ai][1][m][1], ra, s11) + bg1;
#pragma unroll
                for (int j = 0; j < 4; ++j) { o0v[j] = v0[j] * sigm(g0[j]); o1v[j] = v1[j] * sigm(g1[j]); }
                ST16(GL, o0 + (unsigned)((ai * 128 + m * 16) * DM) * 2u, pack8(o0v, o1v)); }
    }
};

struct Args { const float* in[35]; float* out; unsigned char* ws; int ph_lo, ph_hi; };
enum { I_X = 0, I_C, I_CTX, I_CCTX, I_MODW, I_MODB, I_NMIXG, I_NFFNG, I_FING, I_ABWIN, I_ABWOUT, I_LCW, I_LCB, I_LWR, I_LBR, I_LWI, I_LBI, I_LLAM, I_SINK,
       I_CMWIN, I_CMBIN, I_CMDWW, I_CMDWB, I_CMLNG, I_CMLNB, I_CMWOUT, I_CMBOUT, I_RW, I_RB, I_EW1, I_EW3, I_EW2, I_SW1, I_SW3, I_SW2 };

__device__ __forceinline__ int linv32(int nn) { return 8 * ((nn >> 2) & 3) + 4 * (nn >> 4) + (nn & 3); }
__device__ __forceinline__ int t21map(int nn) { return 8 * ((nn >> 4) + 2 * ((nn >> 3) & 1)) + (nn & 7); }
__device__ __forceinline__ void tr_item(const float* W, int K, int N, int k0, int n0, bf16_t* WT, int drow0, bool perm, bool frag, LAS float* scr, int lane) {
    f32x4 v[8];
#pragma unroll
    for (int i = 0; i < 8; ++i) v[i] = *(const f32x4*)(W + (size_t)(k0 + i * 8 + (lane >> 3)) * N + n0 + 4 * (lane & 7));
#pragma unroll
    for (int i = 0; i < 8; ++i) { LAS float* s = scr + (i * 8 + (lane >> 3)) * 33 + 4 * (lane & 7); s[0] = v[i][0]; s[1] = v[i][1]; s[2] = v[i][2]; s[3] = v[i][3]; }
    LDS_WAIT(); asm volatile("" ::: "memory");
    const int c = lane & 7;
#pragma unroll
    for (int j = 0; j < 4; ++j) { const int n = (lane >> 3) + 8 * j; const LAS float* s = scr + (8 * c) * 33 + n;
        u32x4 o; o.x = cvt_pk_bf16(s[0 * 33], s[1 * 33]); o.y = cvt_pk_bf16(s[2 * 33], s[3 * 33]); o.z = cvt_pk_bf16(s[4 * 33], s[5 * 33]); o.w = cvt_pk_bf16(s[6 * 33], s[7 * 33]);
        const int dr = drow0 + (perm ? linv32(n) : n);
        if (frag) *(u32x4*)(WT + (size_t)((((dr >> 5) * 64 + (k0 >> 4) + (c >> 1)) * 64 + (c & 1) * 32 + (dr & 31)) * 8)) = o;
        else *(u32x4*)(WT + (size_t)dr * K + k0 + 8 * c) = o; }
    LDS_WAIT(); asm volatile("" ::: "memory");
}
constexpr int IT_WIN = 16 * 56, IT_SQ = 16 * 32, IT_CIN = 16 * 64, IT_RT = 16 * 8;
constexpr int IT_DENSE = IT_WIN + IT_SQ + IT_CIN + IT_SQ + 2 * IT_RT;
constexpr int IT_EXP = 2 * NE1 * 128;
constexpr int IT_Q = 2 * NE1 * 16;
__device__ __forceinline__ void tr_item_fp8(const float* W, int K, int N, int k0, int n0, unsigned char* WT, LAS float* scr, int lane) {
    f32x4 v[8];
#pragma unroll
    for (int i = 0; i < 8; ++i) v[i] = *(const f32x4*)(W + (size_t)(k0 + i * 8 + (lane >> 3)) * N + n0 + 4 * (lane & 7));
#pragma unroll
    for (int i = 0; i < 8; ++i) { LAS float* s = scr + (i * 8 + (lane >> 3)) * 33 + 4 * (lane & 7); s[0] = v[i][0]; s[1] = v[i][1]; s[2] = v[i][2]; s[3] = v[i][3]; }
    LDS_WAIT(); asm volatile("" ::: "memory");
    const int c = lane & 7;
#pragma unroll
    for (int j = 0; j < 4; ++j) { const int n = (lane >> 3) + 8 * j; const LAS float* s = scr + (8 * c) * 33 + n;
        const f32x4 a = {16.f * s[0 * 33], 16.f * s[1 * 33], 16.f * s[2 * 33], 16.f * s[3 * 33]}, b = {16.f * s[4 * 33], 16.f * s[5 * 33], 16.f * s[6 * 33], 16.f * s[7 * 33]};
        *(u32x2*)(WT + (size_t)(n0 + n) * K + k0 + 8 * c) = pack8_fp8(a, b); }
    LDS_WAIT(); asm volatile("" ::: "memory");
}
struct TrDesc { const float* W; void* dst; int K, N, k0, n0; bool f8; };
__device__ __forceinline__ TrDesc tr_decode(const Args& a, int it) {
    unsigned char* ws = a.ws; TrDesc d; d.f8 = false; int r = it;
    if (r < IT_SQ) { d.W = a.in[I_ABWOUT]; d.K = 1024; d.N = 1024; d.k0 = (r / 32) * 64; d.n0 = (r % 32) * 32; d.dst = ws + WS_WOUT; d.f8 = true; return d; } r -= IT_SQ;
    if (r < IT_SQ) { d.W = a.in[I_CMWOUT]; d.K = 1024; d.N = 1024; d.k0 = (r / 32) * 64; d.n0 = (r % 32) * 32; d.dst = ws + WS_COUT; d.f8 = true; return d; } r -= IT_SQ;
    if (r < 2 * IT_RT) { const int l = r / IT_RT, q = r % IT_RT; d.W = a.in[I_RW] + (size_t)l * 1024 * 256; d.K = 1024; d.N = 256; d.k0 = (q / 8) * 64; d.n0 = (q % 8) * 32; d.dst = (bf16_t*)(ws + WS_RT) + (size_t)l * 256 * 1024; return d; } r -= 2 * IT_RT;
    const int l = r / (NE1 * 128), r2 = r % (NE1 * 128), e = r2 >> 7, qq = r2 & 127;
    d.W = (e < NEXP) ? a.in[I_EW2] + (size_t)(l * NEXP + e) * 256 * 1024 : a.in[I_SW2] + (size_t)l * 256 * 1024;
    d.K = 256; d.N = 1024; d.k0 = (qq >> 5) * 64; d.n0 = (qq & 31) * 32; d.dst = ws + WS_E2 + (size_t)(l * NE1 + e) * 1024 * 256; d.f8 = true; return d;
}
__device__ __forceinline__ u32x4 pack16_fp8(const f32x4 (&v)[16], int jn) { u32x4 o;
#pragma unroll
    for (int d = 0; d < 4; ++d) { int w = 0; w = __builtin_amdgcn_cvt_pk_fp8_f32(16.f * v[4 * d][jn], 16.f * v[4 * d + 1][jn], w, false); w = __builtin_amdgcn_cvt_pk_fp8_f32(16.f * v[4 * d + 2][jn], 16.f * v[4 * d + 3][jn], w, true); o[d] = (unsigned)w; }
    return o; }
__device__ __forceinline__ void p0_convert(const Args& a, LAS unsigned char* lds, int gw, int NGW, int wave, int lane) {
    LAS float* scr = (LAS float*)(lds + wave * 16384);
    for (int it = gw; it < 2 * IT_SQ + 2 * IT_RT; it += NGW) { const TrDesc d = tr_decode(a, it); if (d.f8) tr_item_fp8(d.W, d.K, d.N, d.k0, d.n0, (unsigned char*)d.dst, scr, lane); else tr_item(d.W, d.K, d.N, d.k0, d.n0, (bf16_t*)d.dst, d.n0, false, true, scr, lane); }
    constexpr int NW2 = 2 * NE1 * 64;
    const int g = lane >> 3, q = lane & 7;
#define W2_DECODE(it_) const int l_ = (it_) / (NE1 * 64), r2_ = (it_) % (NE1 * 64), e_ = r2_ >> 6, kp_ = (r2_ >> 5) & 1, nb_ = r2_ & 31; \
        const float* W_ = (e_ < NEXP) ? a.in[I_EW2] + (size_t)(l_ * NEXP + e_) * 256 * 1024 : a.in[I_SW2] + (size_t)l_ * 256 * 1024; \
        unsigned char* D_ = a.ws + WS_E2 + (size_t)(l_ * NE1 + e_) * 1024 * 256; (void)D_;
#define W2_LOAD(buf, it_) do { W2_DECODE(it_); _Pragma("unroll") for (int i = 0; i < 16; ++i) buf[i] = __builtin_nontemporal_load((const f32x4*)(W_ + (size_t)(128 * kp_ + 16 * g + i) * 1024 + nb_ * 32 + 4 * q)); } while (0)
#define W2_STORE(buf, it_) do { W2_DECODE(it_); (void)W_; _Pragma("unroll") for (int jn = 0; jn < 4; ++jn) __builtin_nontemporal_store(pack16_fp8(buf, jn), (u32x4*)(D_ + (size_t)(nb_ * 32 + 4 * q + jn) * 256 + 128 * kp_ + 16 * g)); } while (0)
    f32x4 va[16], vb[16];
    if (gw < NW2) W2_LOAD(va, gw);
    for (int it = gw; it < NW2; it += 2 * NGW) {
        if (it + NGW < NW2) W2_LOAD(vb, it + NGW);
        __builtin_amdgcn_sched_barrier(0);
        W2_STORE(va, it);
        __builtin_amdgcn_sched_barrier(0);
        if (it + NGW < NW2) {
            if (it + 2 * NGW < NW2) W2_LOAD(va, it + 2 * NGW);
            __builtin_amdgcn_sched_barrier(0);
            W2_STORE(vb, it + NGW);
            __builtin_amdgcn_sched_barrier(0);
        }
    }
#undef W2_DECODE
#undef W2_LOAD
#undef W2_STORE
}
__device__ __forceinline__ void p0_quant(const Args& a, LAS unsigned char* lds, int bid, int G, int dry) {
    const int tid = threadIdx.x, w = tid >> 6, lane = tid & 63, g = lane >> 3, q = lane & 7;
    LAS float* pm = (LAS float*)lds;
    constexpr int NIT = IT_Q + 56 + 64;
#define Q_DECODE(it_) const float* W; int ldw, n0, drow0; bool perm = false; const bool t21 = (it_) < IT_Q; signed char* dst; float* sb; \
        if ((it_) < IT_Q) { const int l_ = (it_) / (NE1 * 16), r2_ = (it_) % (NE1 * 16), e_ = r2_ >> 4, which_ = (r2_ >> 3) & 1, nb_ = r2_ & 7; n0 = nb_ * 32; ldw = 256; \
            W = (e_ < NEXP) ? a.in[which_ ? I_EW3 : I_EW1] + (size_t)(l_ * NEXP + e_) * 1024 * 256 : a.in[which_ ? I_SW3 : I_SW1] + (size_t)l_ * 1024 * 256; \
            drow0 = (n0 >> 7) * 256 + (n0 & 127) + (which_ ? 128 : 0); \
            dst = (signed char*)(a.ws + WS_E13) + (size_t)(l_ * NE1 + e_) * 512 * 1024; sb = (float*)(a.ws + WS_SB13) + (size_t)(l_ * NE1 + e_) * 512; } \
        else if ((it_) < IT_Q + 56) { n0 = ((it_) - IT_Q) * 32; ldw = 1792; W = a.in[I_ABWIN]; drow0 = n0; perm = (n0 >= 1024 && n0 < 1664); dst = (signed char*)(a.ws + WS_WIN); sb = (float*)(a.ws + WS_SBW); } \
        else { n0 = ((it_) - IT_Q - 56) * 32; ldw = 2048; W = a.in[I_CMWIN]; const int nn_ = n0 & 1023; drow0 = (nn_ >> 7) * 256 + (nn_ & 127) + (n0 >= 1024 ? 128 : 0); dst = (signed char*)(a.ws + WS_CIN); sb = (float*)(a.ws + WS_SBW) + 1792; }
#define Q_LOAD(buf, it_) do { Q_DECODE(it_); (void)drow0; (void)perm; (void)t21; (void)dst; (void)sb; _Pragma("unroll") for (int i = 0; i < 16; ++i) buf[i] = __builtin_nontemporal_load((const f32x4*)(W + (size_t)(128 * w + 16 * g + i) * ldw + n0 + 4 * q)); } while (0)
#define Q_BODY(buf, it_, par_) do { if (dry == 1) break; Q_DECODE(it_); \
        f32x4 m4 = {0.f, 0.f, 0.f, 0.f}; _Pragma("unroll") for (int i = 0; i < 16; ++i) m4 = __builtin_elementwise_max(m4, __builtin_elementwise_abs(buf[i])); \
        LAS float* pmp = pm + (par_) * 2048; \
        *(LAS f32x4*)(pmp + (w * 8 + g) * 32 + 4 * q) = m4; \
        BAR_LDS();                                                        \
        _Pragma("unroll 8") for (int p = 0; p < 64; ++p) m4 = __builtin_elementwise_max(m4, *(const LAS f32x4*)(pmp + p * 32 + 4 * q)); \
        f32x4 sc4, iv4; _Pragma("unroll") for (int jn = 0; jn < 4; ++jn) { sc4[jn] = (m4[jn] > 0.f) ? m4[jn] * (1.f / 127.f) : 1.f; iv4[jn] = 1.f / sc4[jn]; } \
        if (w == 0 && g == 0) { _Pragma("unroll") for (int jn = 0; jn < 4; ++jn) { const int nn = 4 * q + jn; sb[drow0 + (perm ? linv32(nn) : (t21 ? t21map(nn) : nn))] = sc4[jn]; } } \
        _Pragma("unroll") for (int jn = 0; jn < 4; ++jn) { u32x4 o; \
            _Pragma("unroll") for (int d = 0; d < 4; ++d) { unsigned pk = 0u; \
                _Pragma("unroll") for (int e = 0; e < 4; ++e) { int qi = (int)__builtin_rintf(buf[4 * d + e][jn] * iv4[jn]); qi = min(max(qi, -127), 127); pk |= ((unsigned)qi & 0xffu) << (8 * e); } o[d] = pk; } \
            const int nn = 4 * q + jn; if (dry != 2 || n0 < 0) __builtin_nontemporal_store(o, (u32x4*)(dst + (size_t)(drow0 + (perm ? linv32(nn) : (t21 ? t21map(nn) : nn))) * 1024 + 128 * w + 16 * g)); } } while (0)
    f32x4 va[16], vb[16];
    if (bid < NIT) Q_LOAD(va, bid);
    for (int it = bid; it < NIT; it += 2 * G) {
        if (it + G < NIT) Q_LOAD(vb, it + G);
        __builtin_amdgcn_sched_barrier(0);
        Q_BODY(va, it, 0);
        __builtin_amdgcn_sched_barrier(0);
        if (it + G < NIT) {
            if (it + 2 * G < NIT) Q_LOAD(va, it + 2 * G);
            __builtin_amdgcn_sched_barrier(0);
            Q_BODY(vb, it + G, 1);
            __builtin_amdgcn_sched_barrier(0);
        }
    }
#undef Q_DECODE
#undef Q_LOAD
#undef Q_BODY
}
__device__ __forceinline__ void p0_mod(const Args& a, LAS unsigned char* lds, int tid, int G, int bid) {
    LAS float* sc = (LAS float*)lds;
    LAS float* red = (LAS float*)(lds + 17 * 1024 * 4);
    for (int i = tid; i < 17 * 1024; i += 512) { const int r = i >> 10, k = i & 1023; const float v = (r < 16) ? a.in[I_C][r * 1024 + k] : a.in[I_CCTX][k]; sc[i] = v * sigm(v); }
    __syncthreads();
    float* MOD = (float*)(a.ws + WS_MOD);
    const int cq = tid & 15, kq = tid >> 4, wv = tid >> 6;
    for (int slab = bid; slab < 192; slab += G) {
        const int cg = slab * 64, l = cg / 6144, cc0 = cg % 6144;
        const float* wp = a.in[I_MODW] + (size_t)l * 1024 * 6144 + cc0 + 4 * cq;
        f32x4 acc[17];
#pragma unroll
        for (int r = 0; r < 17; ++r) acc[r] = (f32x4){0.f, 0.f, 0.f, 0.f};
#pragma unroll 8
        for (int k = kq; k < 1024; k += 32) { const f32x4 w = *(const f32x4*)(wp + (size_t)k * 6144);
#pragma unroll
            for (int r = 0; r < 17; ++r) acc[r] += w * sc[r * 1024 + k]; }
#pragma unroll
        for (int r = 0; r < 17; ++r)
#pragma unroll
            for (int j = 0; j < 4; ++j) { float v = acc[r][j]; v += __shfl_xor(v, 16); v += __shfl_xor(v, 32); acc[r][j] = v; }
        if ((tid & 63) < 16) {
#pragma unroll
            for (int r = 0; r < 17; ++r) *(LAS f32x4*)(red + (wv * 17 + r) * 64 + 4 * cq) = acc[r]; }
        __syncthreads();
        for (int i = tid; i < 17 * 64; i += 512) { const int r = i >> 6, c2 = i & 63; float s2 = a.in[I_MODB][l * 6144 + cc0 + c2];
#pragma unroll
            for (int w = 0; w < 8; ++w) s2 += red[(w * 17 + r) * 64 + c2];
            MOD[(size_t)(l * 17 + r) * 6144 + cc0 + c2] = s2; }
        __syncthreads();
    }
}
__device__ __forceinline__ void p0_small(const Args& a, int gtid, int GT) {
    float* rope = (float*)(a.ws + WS_ROPE);
    for (int i = gtid; i < 1024; i += GT) { const int pos = i >> 4, f = i & 15; const double inv = pow(10000.0, -(double)f / 16.0), ang = (double)pos * inv; rope[2 * i] = (float)cos(ang); rope[2 * i + 1] = (float)sin(ang); }
    bf16_t* gw = (bf16_t*)(a.ws + WS_GW);
    for (int i = gtid; i < 2 * 2 * 8 * 64 * 64; i += GT) { const int k = i & 63, n = (i >> 6) & 63, h = (i >> 12) & 7, typ = (i >> 15) & 1, dir = i >> 16;
        const float v = a.in[typ ? I_LWI : I_LWR][(size_t)((dir * 8 + h) * 64 + k) * 64 + n]; gw[i] = (bf16_t)(cvt_pk_bf16(v, 0.f) & 0xffffu); }
}

__device__ __forceinline__ void quant_row_store(const f32x4 (&o)[4], signed char* row8, float* sc_out, int lane) {
    float mx = 0.f;
#pragma unroll
    for (int j = 0; j < 4; ++j) mx = fmaxf(fmaxf(mx, fmaxf(fabsf(o[j][0]), fabsf(o[j][1]))), fmaxf(fabsf(o[j][2]), fabsf(o[j][3])));
    mx = wave_max(mx); const float sca = (mx > 0.f) ? mx * (1.f / 127.f) : 1.f, iv = 1.f / sca;
    if (lane == 0) *sc_out = sca;
#pragma unroll
    for (int j = 0; j < 4; ++j) { unsigned pk = 0u;
#pragma unroll
        for (int e = 0; e < 4; ++e) { int qi = (int)__builtin_rintf(o[j][e] * iv); qi = qi > 127 ? 127 : (qi < -127 ? -127 : qi); pk |= ((unsigned)qi & 0xffu) << (8 * e); }
        *(unsigned*)(row8 + 256 * j + 4 * lane) = pk; }
}
__device__ __forceinline__ void p1_norm(const Args& a, int gw, int NGW, int lane) {
    const float* MOD = (const float*)(a.ws + WS_MOD); signed char* H8 = (signed char*)(a.ws + WS_H); float* SAH = (float*)(a.ws + WS_SAH); const float* g = a.in[I_NMIXG];
    for (int m0 = gw; m0 < MROWS; m0 += 3 * NGW) {
        f32x4 v[3][4];
#pragma unroll
        for (int r = 0; r < 3; ++r) { const int m = m0 + r * NGW; if (m < MROWS) { const float* xr = (m < T) ? a.in[I_X] + (size_t)m * DM : a.in[I_CTX] + (size_t)(m - T) * DM;
#pragma unroll
                for (int j = 0; j < 4; ++j) v[r][j] = *(const f32x4*)(xr + 256 * j + 4 * lane); } }
        __builtin_amdgcn_sched_barrier(0);
#pragma unroll
        for (int r = 0; r < 3; ++r) { const int m = m0 + r * NGW; if (m < MROWS) { const float* md = (m < T) ? MOD + (size_t)(m >> 11) * 6144 : MOD + (size_t)16 * 6144;
                if (m < T) {
#pragma unroll
                    for (int j = 0; j < 4; ++j) { u32x2 w; w.x = cvt_pk_bf16(v[r][j][0], v[r][j][1]); w.y = cvt_pk_bf16(v[r][j][2], v[r][j][3]); *(u32x2*)((bf16_t*)(a.ws + WS_X) + (size_t)m * DM + 256 * j + 4 * lane) = w; } }
                float s = 0.f;
#pragma unroll
                for (int j = 0; j < 4; ++j) s += (v[r][j][0] * v[r][j][0] + v[r][j][1] * v[r][j][1]) + (v[r][j][2] * v[r][j][2] + v[r][j][3] * v[r][j][3]);
                const float rstd = rsqrtf(wave_sum(s) * (1.f / DM) + EPS);
#pragma unroll
                for (int j = 0; j < 4; ++j) { const int c = 256 * j + 4 * lane; const f32x4 gg = *(const f32x4*)(g + c), sh = *(const f32x4*)(md + c), sc = *(const f32x4*)(md + 1024 + c);
                    v[r][j] = v[r][j] * rstd * gg * (sc + 1.f) + sh; }
                quant_row_store(v[r], H8 + (size_t)m * DM, SAH + m, lane); } }
    }
}

__device__ __forceinline__ void attn_phase(const Args& a, LAS unsigned char* lds, int G, int c) {
    const int tid = threadIdx.x, wid = __builtin_amdgcn_readfirstlane(tid >> 6), lane = tid & 63, l31 = lane & 31, hh = lane >> 5;
    const bf16_t* Q = (const bf16_t*)(a.ws + WS_Q); const bf16_t* Kb = (const bf16_t*)(a.ws + WS_K); const bf16_t* VT = (const bf16_t*)(a.ws + WS_VT); const bf16_t* VTC = (const bf16_t*)(a.ws + WS_VTC);
    bf16_t* Y1 = (bf16_t*)(a.ws + WS_Y1);
    constexpr int KST = 144, BUFB = 2 * 64 * KST;
    const int ldr = tid >> 3, ldc = tid & 7;
    for (int un = c; un < 512; un += G) {
        const int b = un >> 5, kvh = (un >> 4) & 1, nb = un & 15;
        const int hq = 4 * kvh + (wid >> 1), rh = wid & 1;
        const int q0 = b * SEQ + nb * 128 + rh * 64;
        bf16x8 qf[2][4];
#pragma unroll
        for (int qt = 0; qt < 2; ++qt)
#pragma unroll
            for (int s = 0; s < 4; ++s) qf[qt][s] = *(const bf16x8*)(Q + (size_t)(q0 + 32 * qt + l31) * 512 + hq * 64 + 16 * s + 8 * hh);
        f32x16 O[2][2];
#pragma unroll
        for (int i = 0; i < 2; ++i)
#pragma unroll
            for (int j = 0; j < 2; ++j)
#pragma unroll
                for (int r = 0; r < 16; ++r) O[i][j][r] = 0.f;
        const float sk = a.in[I_SINK][hq] * LOG2E;
        float mrun[2] = {sk, sk}, lrun[2] = {0.f, 0.f};
        const int t_lo = (nb == 0) ? 2 : 0, t_hi = (nb == 15) ? 4 : 6;
        int ti = t_lo, buf = 0;
        u32x4 kreg, vreg;
#define ATT_LOAD(tile) do { const int rw_ = ((tile) < 6) ? (b * SEQ + (nb - 1) * 128 + 64 * (tile) + ldr) : (T + b * CTX + 64 * ((tile) - 6) + ldr); \
            kreg = *(const u32x4*)(Kb + (size_t)rw_ * 128 + kvh * 64 + ldc * 8); vreg = *(const u32x4*)(VT + (size_t)rw_ * 128 + kvh * 64 + ldc * 8); } while (0)
#define ATT_WRITE(bf) do { *(LAS u32x4*)(lds + (bf) * BUFB + ldr * KST + ldc * 16) = kreg; \
            LAS unsigned short* vp_ = (LAS unsigned short*)(lds + (bf) * BUFB + 64 * KST + (8 * ldc) * KST + ldr * 2);     \
            _Pragma("unroll") for (int i_ = 0; i_ < 4; ++i_) { vp_[(2 * i_) * (KST / 2)] = (unsigned short)(vreg[i_] & 0xffffu); vp_[(2 * i_ + 1) * (KST / 2)] = (unsigned short)(vreg[i_] >> 16); } } while (0)
        ATT_LOAD(ti); ATT_WRITE(0);
        __syncthreads();
        for (;;) {
            int nti = ti + 1; if (nti == t_hi) nti = 6;
            if (nti < 10) ATT_LOAD(nti);
            __builtin_amdgcn_sched_barrier(0);
            const int dt = ti - rh;
            const bool part = (ti >= 6) || (dt >= 0 && dt <= 4);
            if (part) {
                const LAS unsigned char* Kt = lds + buf * BUFB; const LAS unsigned char* Vt = Kt + 64 * KST;
                f32x16 S[2][2];
#pragma unroll
                for (int i = 0; i < 2; ++i)
#pragma unroll
                    for (int j = 0; j < 2; ++j)
#pragma unroll
                        for (int r = 0; r < 16; ++r) S[i][j][r] = 0.f;
#pragma unroll
                for (int kt = 0; kt < 2; ++kt)
#pragma unroll
                    for (int s = 0; s < 4; ++s) { const bf16x8 kf = *(const LAS bf16x8*)(Kt + (32 * kt + l31) * KST + (16 * s + 8 * hh) * 2);
#pragma unroll
                        for (int qt = 0; qt < 2; ++qt) S[kt][qt] = __builtin_amdgcn_mfma_f32_32x32x16_bf16(kf, qf[qt][s], S[kt][qt], 0, 0, 0); }
                if (ti < 6 && (dt == 0 || dt == 4)) {
#pragma unroll
                    for (int kt = 0; kt < 2; ++kt)
#pragma unroll
                        for (int qt = 0; qt < 2; ++qt)
#pragma unroll
                            for (int r = 0; r < 16; ++r) { const int kk = 32 * kt + (r & 3) + 8 * (r >> 2) + 4 * hh, qq = 32 * qt + l31;
                                const bool bad = (dt == 0) ? (kk < qq) : (kk > qq); if (bad) S[kt][qt][r] = -INFINITY; }
                }
#pragma unroll
                for (int qt = 0; qt < 2; ++qt) {
                    float mx = S[0][qt][0];
#pragma unroll
                    for (int r = 1; r < 16; ++r) mx = fmaxf(mx, S[0][qt][r]);
#pragma unroll
                    for (int r = 0; r < 16; ++r) mx = fmaxf(mx, S[1][qt][r]);
                    mx = fmaxf(mx, __shfl_xor(mx, 32));
                    const float mn = fmaxf(mrun[qt], mx), al = __builtin_amdgcn_exp2f(mrun[qt] - mn); mrun[qt] = mn;
                    float ps = 0.f;
#pragma unroll
                    for (int kt = 0; kt < 2; ++kt)
#pragma unroll
                        for (int r = 0; r < 16; ++r) { const float p = __builtin_amdgcn_exp2f(S[kt][qt][r] - mn); S[kt][qt][r] = p; ps += p; }
                    lrun[qt] = lrun[qt] * al + ps;
#pragma unroll
                    for (int r = 0; r < 16; ++r) { O[0][qt][r] *= al; O[1][qt][r] *= al; }
                }
#pragma unroll
                for (int kt = 0; kt < 2; ++kt)
#pragma unroll
                    for (int s2 = 0; s2 < 2; ++s2) {
                        bf16x8 pf[2];
#pragma unroll
                        for (int qt = 0; qt < 2; ++qt) { u32x4 w; w.x = cvt_pk_bf16(S[kt][qt][8 * s2 + 0], S[kt][qt][8 * s2 + 1]); w.y = cvt_pk_bf16(S[kt][qt][8 * s2 + 2], S[kt][qt][8 * s2 + 3]);
                            w.z = cvt_pk_bf16(S[kt][qt][8 * s2 + 4], S[kt][qt][8 * s2 + 5]); w.w = cvt_pk_bf16(S[kt][qt][8 * s2 + 6], S[kt][qt][8 * s2 + 7]); pf[qt] = __builtin_bit_cast(bf16x8, w); }
#pragma unroll
                        for (int d2 = 0; d2 < 2; ++d2) { const LAS unsigned char* vp = Vt + (32 * d2 + l31) * KST + (32 * kt + 16 * s2 + 4 * hh) * 2;
                            const u32x2 v0 = *(const LAS u32x2*)vp, v1 = *(const LAS u32x2*)(vp + 16); u32x4 vv; vv.x = v0.x; vv.y = v0.y; vv.z = v1.x; vv.w = v1.y;
                            const bf16x8 vf = __builtin_bit_cast(bf16x8, vv);
#pragma unroll
                            for (int qt = 0; qt < 2; ++qt) O[d2][qt] = __builtin_amdgcn_mfma_f32_32x32x16_bf16(vf, pf[qt], O[d2][qt], 0, 0, 0); }
                    }
            }
            if (nti < 10) ATT_WRITE(buf ^ 1);
            __syncthreads();
            if (nti >= 10) break;
            ti = nti; buf ^= 1;
        }
#undef ATT_LOAD
#undef ATT_WRITE
#pragma unroll
        for (int qt = 0; qt < 2; ++qt) {
            const float lt = lrun[qt] + __shfl_xor(lrun[qt], 32) + __builtin_amdgcn_exp2f(sk - mrun[qt]); const float inv = 1.f / lt;
            unsigned char* op = (unsigned char*)Y1 + (size_t)(q0 + 32 * qt + l31) * DM + 512 + hq * 64;
#pragma unroll
            for (int d2 = 0; d2 < 2; ++d2)
#pragma unroll
                for (int g = 0; g < 4; ++g) { int w = 0; w = __builtin_amdgcn_cvt_pk_fp8_f32(O[d2][qt][4 * g] * inv, O[d2][qt][4 * g + 1] * inv, w, false); w = __builtin_amdgcn_cvt_pk_fp8_f32(O[d2][qt][4 * g + 2] * inv, O[d2][qt][4 * g + 3] * inv, w, true);
                    *(int*)(op + 32 * d2 + 8 * g + 4 * hh) = w; }
        }
    }
}

constexpr int LRU_URAW = 0, LRU_UCF = 17408, LRU_UCB = 33792, LRU_AL = 43008, LRU_BL = 75776, LRU_SEG = 108544, LRU_CAR = 112640, LRU_CARX = 114688;
template <int PASS>
__device__ __forceinline__ void lru_phase(const Args& a, LAS unsigned char* lds, int bid) {
    const int tid = threadIdx.x, wid = __builtin_amdgcn_readfirstlane(tid >> 6), lane = tid & 63, l31 = lane & 31, hh = lane >> 5;
    const int pair = bid >> 1, sub = bid & 1, b = pair >> 3, h = pair & 7;
    const bf16_t* U = (const bf16_t*)(a.ws + WS_U);
    LAS float* uraw = (LAS float*)(lds + LRU_URAW); LAS float* ucf = (LAS float*)(lds + LRU_UCF); LAS unsigned char* ucb = lds + LRU_UCB;
    LAS float* AL = (LAS float*)(lds + LRU_AL); LAS float* BL = (LAS float*)(lds + LRU_BL); LAS float* SEG = (LAS float*)(lds + LRU_SEG); LAS float* CAR = (LAS float*)(lds + LRU_CAR);
    LAS float* CARX = (LAS float*)(lds + LRU_CARX);
    const int ct = tid >> 3, ccg = tid & 7;
    float cw[4][8], cb[8];
#pragma unroll
    for (int j = 0; j < 8; ++j) { cb[j] = a.in[I_LCB][h * 64 + ccg * 8 + j];
#pragma unroll
        for (int k = 0; k < 4; ++k) cw[k][j] = a.in[I_LCW][k * 512 + h * 64 + ccg * 8 + j]; }
    const int gdir = wid & 1, gnt = (wid >> 1) & 1, gth = wid >> 2;
    bf16x8 gbr[4], gbi[4];
    { const bf16_t* gwr = (const bf16_t*)(a.ws + WS_GW) + (size_t)(((gdir * 2 + 0) * 8 + h) * 64 + 32 * gnt + l31) * 64 + 8 * hh; const bf16_t* gwi = gwr + (size_t)8 * 64 * 64;
#pragma unroll
        for (int s = 0; s < 4; ++s) { gbr[s] = *(const bf16x8*)(gwr + 16 * s); gbi[s] = *(const bf16x8*)(gwi + 16 * s); } }
    const int chl = 32 * gnt + l31, chg = h * 64 + chl;
    const float brr = a.in[I_LBR][gdir * 512 + chg], bii = a.in[I_LBI][gdir * 512 + chg];
    const float sp8 = -8.f * log1pf(expf(-a.in[I_LLAM][gdir * 512 + chg]));
    const int dir = tid >> 8, seg = (tid >> 6) & 3, ch = tid & 63;
    if (PASS == 2) {
        const f32x2* AG = (const f32x2*)(a.ws + WS_AG); LAS f32x2* agl = (LAS f32x2*)(lds + LRU_AL);
        f32x2 v[9];
#pragma unroll
        for (int i = 0; i < 9; ++i) { const int q = tid + i * 512, d2 = q / 2304, r = q % 2304, ck = r >> 6, c2 = r & 63; v[i] = AG[(size_t)((b * 2 + d2) * 36 + ck) * 512 + h * 64 + c2]; }
#pragma unroll
        for (int i = 0; i < 9; ++i) agl[tid + i * 512] = v[i];
        __syncthreads();
        if (tid < 128) { const int d2 = tid >> 6, c2 = tid & 63; const LAS f32x2* ag = agl + d2 * 2304 + c2; LAS float* cx = CARX + d2 * 2048 + c2; float H = 0.f;
            if (d2 == 0) { for (int k = 0; k < 4; ++k) { const f32x2 g = ag[k * 64]; H = g[0] * H + g[1]; } for (int j = 0; j < 32; ++j) { cx[j * 64] = H; const f32x2 g = ag[(4 + j) * 64]; H = g[0] * H + g[1]; } }
            else { for (int k = 3; k >= 0; --k) { const f32x2 g = ag[k * 64]; H = g[0] * H + g[1]; } for (int j = 31; j >= 0; --j) { cx[j * 64] = H; const f32x2 g = ag[(4 + j) * 64]; H = g[0] * H + g[1]; } } }
        __syncthreads();
    }
    const int nun = (PASS == 1) ? 18 : 16;
    u32x4 pre0, pre1; bool ok0, ok1;
#define LRU_CHUNK(it) (((PASS == 1) ? 0 : 4) + sub + 2 * (it))
#define LRU_PREFETCH(ck_) do { const bool isx_ = (ck_) >= 4; const int rb_ = isx_ ? b * SEQ : T + b * CTX, sl_ = isx_ ? SEQ : CTX, pp_ = (isx_ ? ((ck_) - 4) * 64 : (ck_) * 64) - 2; \
        { const int r_ = tid >> 3, p_ = pp_ + r_; ok0 = (p_ >= 0 && p_ < sl_); if (ok0) pre0 = *(const u32x4*)(U + (size_t)(rb_ + p_) * 512 + h * 64 + (tid & 7) * 8); } \
        { const int r_ = 64 + (tid >> 3), p_ = pp_ + r_; ok1 = (tid < 24) && (p_ >= 0 && p_ < sl_); if (ok1) pre1 = *(const u32x4*)(U + (size_t)(rb_ + p_) * 512 + h * 64 + (tid & 7) * 8); } } while (0)
#define LRU_UNPACK(PW, okf, dst) do { f32x4 lo_ = {0.f, 0.f, 0.f, 0.f}, hi_ = lo_; if (okf) { const u32x4 pw_ = (PW); lo_ = (f32x4){bf_lo(pw_[0]), bf_hi(pw_[0]), bf_lo(pw_[1]), bf_hi(pw_[1])}; hi_ = (f32x4){bf_lo(pw_[2]), bf_hi(pw_[2]), bf_lo(pw_[3]), bf_hi(pw_[3])}; } \
        *(LAS f32x4*)(dst) = lo_; *(LAS f32x4*)((dst) + 4) = hi_; } while (0)
    LRU_PREFETCH(LRU_CHUNK(0));
    LRU_UNPACK(pre0, ok0, uraw + (tid >> 3) * 64 + (tid & 7) * 8); if (tid < 24) LRU_UNPACK(pre1, ok1, uraw + (64 + (tid >> 3)) * 64 + (tid & 7) * 8);
    __syncthreads();
    for (int it = 0; it < nun; ++it) {
        const int ck = LRU_CHUNK(it);
        const bool isx = ck >= 4; const int rowbase = isx ? b * SEQ : T + b * CTX, p0 = isx ? (ck - 4) * 64 : ck * 64;
        if (it + 1 < nun) LRU_PREFETCH(LRU_CHUNK(it + 1));
        u32x4 gw4 = {0u, 0u, 0u, 0u};
        if (PASS == 2) gw4 = *(const u32x4*)((const bf16_t*)(a.ws + WS_G) + (size_t)(rowbase + p0 + ct) * 512 + h * 64 + ccg * 8);
        { float o[8];
#pragma unroll
            for (int j = 0; j < 8; ++j) o[j] = cb[j];
#pragma unroll
            for (int k = 0; k < 4; ++k) { const f32x4 u0 = *(const LAS f32x4*)(uraw + (ct + k) * 64 + ccg * 8), u1 = *(const LAS f32x4*)(uraw + (ct + k) * 64 + ccg * 8 + 4);
#pragma unroll
                for (int j = 0; j < 4; ++j) { o[j] += cw[k][j] * u0[j]; o[4 + j] += cw[k][4 + j] * u1[j]; } }
            *(LAS f32x4*)(ucf + ct * 64 + ccg * 8) = (f32x4){o[0], o[1], o[2], o[3]}; *(LAS f32x4*)(ucf + ct * 64 + ccg * 8 + 4) = (f32x4){o[4], o[5], o[6], o[7]};
            u32x4 w; w.x = cvt_pk_bf16(o[0], o[1]); w.y = cvt_pk_bf16(o[2], o[3]); w.z = cvt_pk_bf16(o[4], o[5]); w.w = cvt_pk_bf16(o[6], o[7]);
            *(LAS u32x4*)(ucb + ct * 144 + ccg * 16) = w; }
        BAR_LDS();
        if (it + 1 < nun) { LRU_UNPACK(pre0, ok0, uraw + (tid >> 3) * 64 + (tid & 7) * 8); if (tid < 24) LRU_UNPACK(pre1, ok1, uraw + (64 + (tid >> 3)) * 64 + (tid & 7) * 8); }
        { f32x16 ar, ai;
#pragma unroll
            for (int r = 0; r < 16; ++r) { ar[r] = 0.f; ai[r] = 0.f; }
#pragma unroll
            for (int s = 0; s < 4; ++s) { const bf16x8 af = *(const LAS bf16x8*)(ucb + (32 * gth + l31) * 144 + (16 * s + 8 * hh) * 2);
                ar = __builtin_amdgcn_mfma_f32_32x32x16_bf16(af, gbr[s], ar, 0, 0, 0); ai = __builtin_amdgcn_mfma_f32_32x32x16_bf16(af, gbi[s], ai, 0, 0, 0); }
#pragma unroll
            for (int r = 0; r < 16; ++r) { const int tk = 32 * gth + (r & 3) + 8 * (r >> 2) + 4 * hh;
                const float rg = sigm(ar[r] + brr), ig = sigm(ai[r] + bii), la = sp8 * rg, av = __expf(la), mult = __builtin_amdgcn_sqrtf(fmaxf(1.f - av * av, 0.f));
                AL[gdir * 4096 + tk * 64 + chl] = av; BL[gdir * 4096 + tk * 64 + chl] = mult * ig * ucf[tk * 64 + chl]; } }
        BAR_LDS();
        LAS float* al = AL + dir * 4096 + ch; LAS float* bl = BL + dir * 4096 + ch;
        { float hs = 0.f, P = 1.f;
#pragma unroll
            for (int jj = 0; jj < 16; ++jj) { const int j = 16 * seg + jj, tk = dir ? 63 - j : j; const float av = al[tk * 64], bv = bl[tk * 64]; hs = av * hs + bv; P *= av;
                if (PASS == 2) { bl[tk * 64] = hs; al[tk * 64] = P; } }
            SEG[((dir * 4 + seg) * 64 + ch) * 2] = P; SEG[((dir * 4 + seg) * 64 + ch) * 2 + 1] = hs; }
        BAR_LDS();
        if (PASS == 1) {
            if (seg == 0) { float H = 0.f, A = 1.f;
#pragma unroll
                for (int s = 0; s < 4; ++s) { const float P = SEG[((dir * 4 + s) * 64 + ch) * 2], hs = SEG[((dir * 4 + s) * 64 + ch) * 2 + 1]; H = P * H + hs; A *= P; }
                f32x2* AG = (f32x2*)(a.ws + WS_AG); AG[(size_t)((b * 2 + dir) * 36 + ck) * 512 + h * 64 + ch] = (f32x2){A, H}; }
        } else {
            if (seg == 0) { float cv = CARX[dir * 2048 + (ck - 4) * 64 + ch];
#pragma unroll
                for (int s = 0; s < 4; ++s) { CAR[(dir * 4 + s) * 64 + ch] = cv; const float P = SEG[((dir * 4 + s) * 64 + ch) * 2], hs = SEG[((dir * 4 + s) * 64 + ch) * 2 + 1]; cv = P * cv + hs; } }
            BAR_LDS();
            { const float cs = CAR[(dir * 4 + seg) * 64 + ch];
#pragma unroll
                for (int jj = 0; jj < 16; ++jj) { const int j = 16 * seg + jj, tk = dir ? 63 - j : j; bl[tk * 64] += al[tk * 64] * cs; } }
            BAR_LDS();
            { float gv[8] = {bf_lo(gw4.x), bf_hi(gw4.x), bf_lo(gw4.y), bf_hi(gw4.y), bf_lo(gw4.z), bf_hi(gw4.z), bf_lo(gw4.w), bf_hi(gw4.w)};
                float o[8];
#pragma unroll
                for (int j = 0; j < 8; ++j) { const float rec = BL[ct * 64 + ccg * 8 + j] + BL[4096 + ct * 64 + ccg * 8 + j]; const float x = gv[j];
                    const float ge = x * sigm(1.5957691216f * (x + 0.044715f * x * x * x)); o[j] = ge * rec; }
                *(u32x2*)((unsigned char*)(a.ws + WS_Y1) + (size_t)(rowbase + p0 + ct) * DM + h * 64 + ccg * 8) = pack8_fp8((f32x4){o[0], o[1], o[2], o[3]}, (f32x4){o[4], o[5], o[6], o[7]}); }
        }
        BAR_LDS();
    }
#undef LRU_CHUNK
#undef LRU_PREFETCH
#undef LRU_UNPACK
}

constexpr int RT_HT = 0, RT_LG = 0, RT_LCNT = 132096, RT_LBASE = 133120, RT_LE = 134144, RT_LR = 138240, RT_LW = 142336, RT_GS = 146432;
__device__ __forceinline__ void router_phase(const Args& a, LAS unsigned char* lds, int l, int bid, int G, int commit) {
    const int tid = threadIdx.x, wid = __builtin_amdgcn_readfirstlane(tid >> 6), lane = tid & 63, l31 = lane & 31, hh = lane >> 5;
    const bf16_t* X = (const bf16_t*)(a.ws + WS_X); const float* SSQ = (const float*)(a.ws + WS_SSQ); const float* MOD = (const float*)(a.ws + WS_MOD) + (size_t)l * 17 * 6144;
    signed char* H8 = (signed char*)(a.ws + WS_H); float* SA = (float*)(a.ws + WS_SA); const bf16_t* RT = (const bf16_t*)(a.ws + WS_RT) + (size_t)l * 256 * 1024;
    const float* gff = a.in[I_NFFNG] + l * DM; const float* rbias = a.in[I_RB] + l * NEXP;
    LAS unsigned char* HT = lds + RT_HT; LAS float* LG = (LAS float*)(lds + RT_LG); LAS unsigned* LCNT = (LAS unsigned*)(lds + RT_LCNT); LAS unsigned* LBASE = (LAS unsigned*)(lds + RT_LBASE);
    LAS int* LE = (LAS int*)(lds + RT_LE); LAS int* LR = (LAS int*)(lds + RT_LR); LAS float* LW = (LAS float*)(lds + RT_LW);
    { int* st = (int*)(a.ws + WS_SLOT_TOK); float* sg = (float*)(a.ws + WS_SLOT_GATE); float* ssa = (float*)(a.ws + WS_SLOT_SA); for (int i = bid * 512 + tid; i < MAXSLOT; i += G * 512) { st[i] = 0; sg[i] = 0.f; ssa[i] = 0.f; } }
    if (tid < 256) LCNT[tid] = 0u;
    __syncthreads();
    const int t0 = bid * 128;
    for (int pair = 0; pair < 2; ++pair) {
        { const int tb = t0 + pair * 64 + wid * 4, b = tb >> 11; const float* md = MOD + (size_t)b * 6144;
            f32x4 gg[4], sh[4], sc[4];
#pragma unroll
            for (int j = 0; j < 4; ++j) { const int c = 256 * j + 4 * lane; gg[j] = *(const f32x4*)(gff + c); sh[j] = *(const f32x4*)(md + 3 * 1024 + c); sc[j] = *(const f32x4*)(md + 4 * 1024 + c) + 1.f; }
            u32x2 raw[2][4][4]; float ssl[2][4];
#define RT_XLOAD(r_) do { _Pragma("unroll") for (int q = 0; q < 4; ++q) { const int t = tb + 32 * (r_) + q; ssl[r_][q] = (lane < 16) ? SSQ[(size_t)t * 16 + lane] : 0.f; \
                _Pragma("unroll") for (int j = 0; j < 4; ++j) raw[r_][q][j] = *(const u32x2*)(X + (size_t)t * DM + 256 * j + 4 * lane); } } while (0)
            RT_XLOAD(0);
#pragma unroll
            for (int r = 0; r < 2; ++r) {
                if (r == 0) RT_XLOAD(1);
                __builtin_amdgcn_sched_barrier(0);
#pragma unroll
                for (int q = 0; q < 4; ++q) { const int tl = 32 * r + wid * 4 + q, t = tb + 32 * r + q;
                    const float rstd = rsqrtf(wave_sum(ssl[r][q]) * (1.f / DM) + EPS); f32x4 ov[4];
#pragma unroll
                    for (int j = 0; j < 4; ++j) { const int c = 256 * j + 4 * lane; const u32x2 w0 = raw[r][q][j]; const f32x4 xq = {bf_lo(w0.x), bf_hi(w0.x), bf_lo(w0.y), bf_hi(w0.y)};
                        const f32x4 o = xq * rstd * gg[j] * sc[j] + sh[j]; ov[j] = o; u32x2 w; w.x = cvt_pk_bf16(o[0], o[1]); w.y = cvt_pk_bf16(o[2], o[3]);
                        *(LAS u32x2*)(HT + tl * 2064 + c * 2) = w; }
                    quant_row_store(ov, H8 + (size_t)t * DM, SA + t, lane); }
                __builtin_amdgcn_sched_barrier(0); } }
#undef RT_XLOAD
        __syncthreads();
        if (commit == 3) continue;
        { f32x16 acc[2][2];
#pragma unroll
            for (int r = 0; r < 16; ++r) { acc[0][0][r] = 0.f; acc[0][1][r] = 0.f; acc[1][0][r] = 0.f; acc[1][1][r] = 0.f; }
            const GAS char* bps = (const GAS char*)((const char*)RT + (size_t)wid * 65536); asm volatile("" : "+s"(bps));
            const unsigned bvo = (unsigned)lane * 16u; const LAS unsigned char* ap = HT + l31 * 2064 + 16 * hh;
            const LAS unsigned char* ap1 = ap + 32 * 2064; asm volatile("" : "+v"(ap1));
            bf16x8 bq[3][8];
#pragma unroll
            for (int i = 0; i < 8; ++i) bq[0][i] = *(const GAS bf16x8*)(bps + 1024 * i + bvo);
#pragma unroll
            for (int i = 0; i < 8; ++i) bq[1][i] = *(const GAS bf16x8*)(bps + 1024 * (8 + i) + bvo);
            __builtin_amdgcn_sched_barrier(0);
#pragma unroll
            for (int g = 0; g < 8; ++g) {
                if (g < 6) {
#pragma unroll
                    for (int i = 0; i < 8; ++i) bq[(g + 2) % 3][i] = *(const GAS bf16x8*)(bps + 1024 * (8 * (g + 2) + i) + bvo); }
                __builtin_amdgcn_sched_barrier(0);
#pragma unroll
                for (int i = 0; i < 8; ++i) { const bf16x8 a0 = *(const LAS bf16x8*)(ap + 32 * (8 * g + i)), a1 = *(const LAS bf16x8*)(ap1 + 32 * (8 * g + i));
                    acc[0][i & 1] = __builtin_amdgcn_mfma_f32_32x32x16_bf16(a0, bq[g % 3][i], acc[0][i & 1], 0, 0, 0); acc[1][i & 1] = __builtin_amdgcn_mfma_f32_32x32x16_bf16(a1, bq[g % 3][i], acc[1][i & 1], 0, 0, 0); }
                __builtin_amdgcn_sched_barrier(0); }
            __syncthreads();
#pragma unroll
            for (int h2 = 0; h2 < 2; ++h2)
#pragma unroll
                for (int r = 0; r < 16; ++r) LG[(32 * h2 + (r & 3) + 8 * (r >> 2) + 4 * hh) * 257 + 32 * wid + l31] = acc[h2][0][r] + acc[h2][1][r]; }
        __syncthreads();
        if (commit == 2) continue;
        for (int rr = 0; rr < 2; ++rr)
        { const int rw = lane >> 4, li = lane & 15, tl = 32 * rr + wid * 4 + rw, e0 = 16 * li;
            float cand[16];
#pragma unroll
            for (int j4 = 0; j4 < 4; ++j4) { const f32x4 rb4 = *(const f32x4*)(rbias + e0 + 4 * j4);
#pragma unroll
                for (int j = 0; j < 4; ++j) cand[4 * j4 + j] = sigm(LG[tl * 257 + e0 + 4 * j4 + j]) + rb4[j]; }
            float m1 = fmaxf(cand[0], cand[1]), m2 = fminf(cand[0], cand[1]);
#pragma unroll
            for (int j = 2; j < 16; ++j) { const float v = cand[j]; m2 = fmaxf(m2, fminf(m1, v)); m1 = fmaxf(m1, v); }
            { const float o1 = dppf<DPP_XOR1, 0xF, true>(0.f, m1), o2 = dppf<DPP_XOR1, 0xF, true>(0.f, m2); const float n1 = fmaxf(m1, o1), n2 = fmaxf(fminf(m1, o1), fmaxf(m2, o2)); m1 = n1; m2 = n2; }
            const float gs = m1 + m2; const int mg = li >> 1;
            LAS float* GS = (LAS float*)(lds + RT_GS) + tl * 8;
            if ((li & 1) == 0) GS[mg] = gs;
            LDS_WAIT(); asm volatile("" ::: "memory");
            int rank = 0;
            { const f32x4 g0 = *(const LAS f32x4*)GS, g1 = *(const LAS f32x4*)(GS + 4);
#pragma unroll
                for (int g2 = 0; g2 < 8; ++g2) { const float v = g2 < 4 ? g0[g2 & 3] : g1[g2 & 3]; rank += (v > gs || (v == gs && g2 < mg)) ? 1 : 0; } }
            unsigned key[16];
#pragma unroll
            for (int j = 0; j < 16; ++j) { unsigned bts = __builtin_bit_cast(unsigned, cand[j]); bts ^= (bts & 0x80000000u) ? 0xffffffffu : 0x80000000u;
                key[j] = (rank >= 4) ? 0u : ((bts & 0xffffff00u) | (unsigned)(255 - (e0 + j))); }
            int my_e = 0; float my_s = 0.f, tot = 0.f; unsigned prev = 0xffffffffu;
            for (int k = 0; k < 8; ++k) {
                unsigned loc = 0u;
#pragma unroll
                for (int j = 0; j < 16; ++j) { const unsigned v = (key[j] < prev) ? key[j] : 0u; loc = loc > v ? loc : v; }
#define RT_STEP(CTRL) do { const unsigned ov = (unsigned)dppi<CTRL, 0xF, false>(0, (int)loc); loc = loc > ov ? loc : ov; } while (0)
                RT_STEP(DPP_XOR1); RT_STEP(DPP_XOR2); RT_STEP(DPP_ROR4); RT_STEP(DPP_ROR8);
#undef RT_STEP
                const int be = 255 - (int)(loc & 0xffu); prev = loc;
                const float bs = sigm(LG[tl * 257 + be]);
                tot += bs;
                if (li == k) { my_e = be; my_s = bs; }
            }
            if (li < 8) { const unsigned lr = __hip_atomic_fetch_add(&LCNT[my_e], 1u, __ATOMIC_RELAXED, __HIP_MEMORY_SCOPE_WORKGROUP); const int ix = (pair * 64 + tl) * 8 + li; LE[ix] = my_e; LR[ix] = (int)lr; LW[ix] = 2.5f * my_s / tot; }
        }
        __syncthreads();
    }
    if (commit != 1) return;
    if (tid < 256) { const unsigned n = LCNT[tid]; unsigned base = 0u; if (n) base = __hip_atomic_fetch_add((unsigned*)(a.ws + WS_CTL) + CW_CNT + (l * 256 + tid) * 64, n, __ATOMIC_RELAXED, __HIP_MEMORY_SCOPE_AGENT); LBASE[tid] = base; }
    __syncthreads();
    { int* TE = (int*)(a.ws + WS_TOK_E); int* TR = (int*)(a.ws + WS_TOK_R); float* TW = (float*)(a.ws + WS_TOK_W);
        for (int i = tid; i < 1024; i += 512) { const int e = LE[i]; TE[(size_t)t0 * 8 + i] = e; TR[(size_t)t0 * 8 + i] = (int)LBASE[e] + LR[i]; TW[(size_t)t0 * 8 + i] = LW[i]; } }
    __syncthreads();
}

__device__ __forceinline__ int build_tables(const Args& a, LAS unsigned char* lds, int l) {
    const int tid = threadIdx.x;
    LAS int* PB = (LAS int*)(lds + LDS_PB_OFF); LAS unsigned short* BLKE = (LAS unsigned short*)(lds + LDS_BLKE_OFF);
    LAS int* NBK = (LAS int*)(lds + LDS_IDX_OFF);
    if (tid < 256) { const unsigned n = __hip_atomic_load((unsigned*)(a.ws + WS_CTL) + CW_CNT + (l * 256 + tid) * 64, __ATOMIC_RELAXED, __HIP_MEMORY_SCOPE_AGENT); NBK[tid] = (int)((n + 255u) >> 8); }
    __syncthreads();
    LAS int* GT16 = NBK + 256;
    if (tid < 16) { int s = 0;
#pragma unroll
        for (int j = 0; j < 16; ++j) s += NBK[16 * tid + j]; GT16[tid] = s; }
    __syncthreads();
    if (tid < 256) { int s = 0; const int gq = tid >> 4, r = tid & 15;
#pragma unroll
        for (int j = 0; j < 16; ++j) { s += (j < gq) ? GT16[j] : 0; s += (j < r) ? NBK[16 * gq + j] : 0; }
        PB[tid] = s; if (tid == 255) { PB[256] = s + NBK[255]; } }
    __syncthreads();
    const int nbr = PB[256];
    if (tid < 256) { const int s = PB[tid], n = NBK[tid]; for (int i = 0; i < n; ++i) BLKE[s + i] = (unsigned short)tid; }
    if (tid < 128) BLKE[nbr + tid] = 256;
    __syncthreads();
    return nbr;
}
__device__ __forceinline__ void slots_phase(const Args& a, LAS unsigned char* lds, int l, int bid) {
    const int tid = threadIdx.x;
    const int nbr = build_tables(a, lds, l);
    LAS int* PB = (LAS int*)(lds + LDS_PB_OFF);
    const int* TE = (const int*)(a.ws + WS_TOK_E); const int* TR = (const int*)(a.ws + WS_TOK_R); const float* TW = (const float*)(a.ws + WS_TOK_W);
    int* TS = (int*)(a.ws + WS_TOK_SLOT); int* ST = (int*)(a.ws + WS_SLOT_TOK); float* SG = (float*)(a.ws + WS_SLOT_GATE); float* SSA = (float*)(a.ws + WS_SLOT_SA); const float* SA = (const float*)(a.ws + WS_SA);
    const int t0 = bid * 128;
    for (int i = tid; i < 1024; i += 512) { const size_t ix = (size_t)t0 * 8 + i; const int e = TE[ix], slot = 256 * PB[e] + TR[ix]; ST[slot] = t0 + (i >> 3); SG[slot] = TW[ix]; SSA[slot] = SA[t0 + (i >> 3)]; TS[ix] = slot; }
    if (tid < 128) { const int slot = 256 * nbr + t0 + tid; ST[slot] = t0 + tid; SG[slot] = 1.f; SSA[slot] = SA[t0 + tid]; }
    if (bid == 0 && tid == 0) *((int*)(a.ws + WS_CTL) + CW_NBR + l * 64) = nbr;
    __syncthreads();
}

__device__ __forceinline__ void combine_phase(const Args& a, int l, int gw, int NGW, int lane) {
    const unsigned char* Y = (const unsigned char*)(a.ws + WS_Y); const int* TS = (const int*)(a.ws + WS_TOK_SLOT); bf16_t* X = (bf16_t*)(a.ws + WS_X); bf16_t* H = (bf16_t*)(a.ws + WS_H);
    const float* MOD = (const float*)(a.ws + WS_MOD);
    const int nbr = *((const int*)(a.ws + WS_CTL) + CW_NBR + l * 64);
    typedef float f2 __attribute__((ext_vector_type(2)));
    const int c0 = 16 * lane;
    const int cb = (lane >> 4) * 256 + ((lane >> 2) & 3) * 32 + (lane & 3) * 8;
#define CQ(q) (cb + ((q) >> 1) * 128 + ((q) & 1) * 4)
    u32x4 yw[1][9]; u32x4 xw[1][2];
#define CMB_SLOTS(t_) (((lane < 8) ? TS[(size_t)(t_) * 8 + lane] : (256 * nbr + (t_))))
#define CMB_LOAD(buf, t_, ms_) do { _Pragma("unroll") for (int k = 0; k < 9; ++k) { const int slot = __builtin_amdgcn_readlane((ms_), k); yw[buf][k] = __builtin_nontemporal_load((const u32x4*)(Y + (size_t)slot * DM + c0)); } \
        xw[buf][0] = *(const u32x4*)(X + (size_t)(t_) * DM + cb); xw[buf][1] = *(const u32x4*)(X + (size_t)(t_) * DM + cb + 128); } while (0)
#define CMB_BODY(buf, t_) do { const int b = (t_) >> 11; float acc[16]; \
        _Pragma("unroll") for (int j = 0; j < 16; ++j) acc[j] = 0.f; \
        _Pragma("unroll") for (int k = 0; k < 9; ++k) _Pragma("unroll") for (int d = 0; d < 4; ++d) { const f2 lo = __builtin_amdgcn_cvt_pk_f32_fp8((int)yw[buf][k][d], false), hi = __builtin_amdgcn_cvt_pk_f32_fp8((int)yw[buf][k][d], true); \
            acc[4 * d] += lo[0]; acc[4 * d + 1] += lo[1]; acc[4 * d + 2] += hi[0]; acc[4 * d + 3] += hi[1]; } \
        const float* g5 = MOD + (size_t)(l * 17 + b) * 6144 + 5 * 1024; float xn[16]; float ss = 0.f; \
        _Pragma("unroll") for (int q = 0; q < 4; ++q) { const f32x4 gv = *(const f32x4*)(g5 + CQ(q)); \
            const unsigned xa = xw[buf][q >> 1][(q & 1) * 2], xb = xw[buf][q >> 1][(q & 1) * 2 + 1]; const f32x4 xq = {bf_lo(xa), bf_hi(xa), bf_lo(xb), bf_hi(xb)}; \
            _Pragma("unroll") for (int j = 0; j < 4; ++j) { const float v = xq[j] + gv[j] * (acc[4 * q + j] * 0.0625f); xn[4 * q + j] = v; ss += v * v; } } \
        const float rstd = rsqrtf(wave_sum(ss) * (1.f / DM) + EPS); \
        if (l == 0) { const float* g1 = a.in[I_NMIXG] + DM; const float* md = MOD + (size_t)(17 + b) * 6144; float o[16]; \
            _Pragma("unroll") for (int q = 0; q < 4; ++q) { const int c = CQ(q); const f32x4 gg = *(const f32x4*)(g1 + c), sh = *(const f32x4*)(md + c), sc = *(const f32x4*)(md + 1024 + c); \
                { u32x2 wx; wx.x = cvt_pk_bf16(xn[4 * q], xn[4 * q + 1]); wx.y = cvt_pk_bf16(xn[4 * q + 2], xn[4 * q + 3]); *(u32x2*)(X + (size_t)(t_) * DM + c) = wx; } \
                _Pragma("unroll") for (int j = 0; j < 4; ++j) o[4 * q + j] = xn[4 * q + j] * rstd * gg[j] * (sc[j] + 1.f) + sh[j]; } \
            float mx = 0.f; _Pragma("unroll") for (int j = 0; j < 16; ++j) mx = fmaxf(mx, fabsf(o[j])); \
            mx = wave_max(mx); const float sca = (mx > 0.f) ? mx * (1.f / 127.f) : 1.f, iv = 1.f / sca; \
            if (lane == 0) ((float*)(a.ws + WS_SAH))[(t_)] = sca; \
            u32x4 w8; _Pragma("unroll") for (int d = 0; d < 4; ++d) { unsigned pk = 0u; \
                _Pragma("unroll") for (int e = 0; e < 4; ++e) { int qi = (int)__builtin_rintf(o[4 * d + e] * iv); qi = qi > 127 ? 127 : (qi < -127 ? -127 : qi); pk |= ((unsigned)qi & 0xffu) << (8 * e); } w8[d] = pk; } \
            *(u32x2*)((signed char*)H + (size_t)(t_) * DM + cb) = (u32x2){w8[0], w8[1]}; *(u32x2*)((signed char*)H + (size_t)(t_) * DM + cb + 128) = (u32x2){w8[2], w8[3]}; \
        } else { const float* gf = a.in[I_FING]; \
            _Pragma("unroll") for (int q = 0; q < 4; ++q) { const int c = CQ(q); const f32x4 gg = *(const f32x4*)(gf + c); \
                *(f32x4*)(a.out + (size_t)(t_) * DM + c) = (f32x4){xn[4 * q] * rstd * gg[0], xn[4 * q + 1] * rstd * gg[1], xn[4 * q + 2] * rstd * gg[2], xn[4 * q + 3] * rstd * gg[3]}; } } } while (0)
    int ms = (gw < T) ? CMB_SLOTS(gw) : 0;
    for (int t = gw; t < T; t += NGW) {
        CMB_LOAD(0, t, ms);
        if (t + NGW < T) ms = CMB_SLOTS(t + NGW);
        __builtin_amdgcn_sched_barrier(0);
        CMB_BODY(0, t);
        __builtin_amdgcn_sched_barrier(0);
    }
#undef CQ
#undef CMB_SLOTS
#undef CMB_LOAD
#undef CMB_BODY
}

__device__ __forceinline__ void conv_phase(const Args& a, LAS unsigned char* lds, int bid, int G) {
    const int tid = threadIdx.x, wid = __builtin_amdgcn_readfirstlane(tid >> 6), lane = tid & 63;
    const bf16_t* GL = (const bf16_t*)(a.ws + WS_GL); bf16_t* ZC = (bf16_t*)(a.ws + WS_ZC);
    LAS float* RED = (LAS float*)(lds + 62 * 2048);
    const int c0 = 2 * tid;
    f32x2 wk[31];
#pragma unroll
    for (int k = 0; k < 31; ++k) wk[k] = *(const f32x2*)(a.in[I_CMDWW] + k * DM + c0);
    const f32x2 bia = *(const f32x2*)(a.in[I_CMDWB] + c0), lng = *(const f32x2*)(a.in[I_CMLNG] + c0), lnb = *(const f32x2*)(a.in[I_CMLNB] + c0);
    u32x4 pre[16];
#define CONV_LOAD(tile_) do { const int b_ = (tile_) >> 6, p0_ = ((tile_) & 63) * 32; _Pragma("unroll") for (int i = 0; i < 16; ++i) { const int q = i * 512 + tid, r = q >> 7, cg = q & 127, p = p0_ - 15 + r; \
            pre[i] = (u32x4){0u, 0u, 0u, 0u}; if (q < 62 * 128 && p >= 0 && p < SEQ) pre[i] = *(const u32x4*)(GL + (size_t)(b_ * SEQ + p) * DM + cg * 8); } } while (0)
    if (bid < T / 32) CONV_LOAD(bid);
    for (int tile = bid; tile < T / 32; tile += G) {
        const int b = tile >> 6, p0 = (tile & 63) * 32;
#pragma unroll
        for (int i = 0; i < 16; ++i) { const int q = i * 512 + tid; if (q < 62 * 128) *(LAS u32x4*)(lds + q * 16) = pre[i]; }
        if (tile + G < T / 32) CONV_LOAD(tile + G);
        __builtin_amdgcn_sched_barrier(0);
        BAR_LDS();
        for (int tb = 0; tb < 4; ++tb) {
            f32x2 z[8];
#pragma unroll
            for (int j = 0; j < 8; ++j) z[j] = bia;
#pragma unroll
            for (int r = 0; r < 38; ++r) { const unsigned u = *(const LAS unsigned*)(lds + (8 * tb + r) * 2048 + c0 * 2); const f32x2 v = {bf_lo(u), bf_hi(u)};
#pragma unroll
                for (int j = 0; j < 8; ++j) { const int k = r - j; if (k >= 0 && k < 31) z[j] = __builtin_elementwise_fma(wk[k], v, z[j]); } }
            float z0[8], z1[8];
#pragma unroll
            for (int j = 0; j < 8; ++j) { z0[j] = z[j][0]; z1[j] = z[j][1]; }
            float st[16];
#pragma unroll
            for (int j = 0; j < 8; ++j) { st[2 * j] = z0[j] + z1[j]; st[2 * j + 1] = z0[j] * z0[j] + z1[j] * z1[j]; }
#pragma unroll
            for (int i = 0; i < 16; ++i) st[i] = wave_sum(st[i]);
            if (lane == 0) {
#pragma unroll
                for (int i = 0; i < 4; ++i) *(LAS f32x4*)(RED + wid * 16 + 4 * i) = (f32x4){st[4 * i], st[4 * i + 1], st[4 * i + 2], st[4 * i + 3]}; }
            BAR_LDS();
            if (tid < 16) { float t = 0.f;
#pragma unroll
                for (int w = 0; w < 8; ++w) t += RED[w * 16 + tid];
                RED[128 + tid] = t; }
            BAR_LDS();
            float tt[16];
#pragma unroll
            for (int i = 0; i < 4; ++i) { const f32x4 v = *(const LAS f32x4*)(RED + 128 + 4 * i); tt[4 * i] = v[0]; tt[4 * i + 1] = v[1]; tt[4 * i + 2] = v[2]; tt[4 * i + 3] = v[3]; }
#pragma unroll
            for (int j = 0; j < 8; ++j) { const float s1 = tt[2 * j], s2 = tt[2 * j + 1];
                const float mu = s1 * (1.f / DM), var = fmaxf(s2 * (1.f / DM) - mu * mu, 0.f), rstd = rsqrtf(var + EPS);
                const float y0 = (z0[j] - mu) * rstd * lng[0] + lnb[0], y1 = (z1[j] - mu) * rstd * lng[1] + lnb[1];
                *(unsigned short*)((unsigned char*)ZC + (size_t)(b * SEQ + p0 + 8 * tb + j) * DM + c0) = (unsigned short)__builtin_amdgcn_cvt_pk_fp8_f32(y0 * sigm(y0), y1 * sigm(y1), 0, false); }
            BAR_LDS();
        }
    }
}

#undef CONV_LOAD
struct Ctx { int tid, lane, wave, G, bid, vcu, gw, NGW; };
__device__ __forceinline__ void ph_inproj(const Args& args, LAS unsigned char* lds, const Ctx& c) {
    unsigned char* ws = args.ws;
    pg8::DenseOrder S; S.init(ws + WS_H, ws + WS_WIN, MROWS, 1792, 512, c.G, c.bid);
    EpiInProj E{(bf16_t*)(ws + WS_U), (bf16_t*)(ws + WS_G), (bf16_t*)(ws + WS_Q), (bf16_t*)(ws + WS_K), (bf16_t*)(ws + WS_VT), (bf16_t*)(ws + WS_VTC), (const float*)(ws + WS_ROPE), (const float*)(ws + WS_SAH), (const float*)(ws + WS_SBW)};
    pg8::gemm_phase<EpiInProj, pg8::DenseOrder, false>(lds, 512, S, E);
}
__device__ __forceinline__ void ph_cin(const Args& args, LAS unsigned char* lds, const Ctx& c) {
    unsigned char* ws = args.ws;
    pg8::DenseOrder S; S.init(ws + WS_H, ws + WS_CIN, T, 2048, 512, c.G, c.bid);
    EpiGlu E{(bf16_t*)(ws + WS_GL), args.in[I_CMBIN], (const float*)(ws + WS_SAH), (const float*)(ws + WS_SBW) + 1792};
    pg8::gemm_phase<EpiGlu, pg8::DenseOrder, false>(lds, 512, S, E);
}
template <int l> __device__ __forceinline__ void ph_resid(const Args& args, LAS unsigned char* lds, const Ctx& c) {
    unsigned char* ws = args.ws;
    pg8::DenseOrder S; S.init(l == 0 ? ws + WS_Y1 : ws + WS_ZC, l == 0 ? ws + WS_WOUT : ws + WS_COUT, T, 1024, 512, c.G, c.bid);
    EpiResid E{(bf16_t*)(ws + WS_X), (const float*)(ws + WS_MOD) + (size_t)l * 17 * 6144 + 2 * 1024, l == 0 ? nullptr : args.in[I_CMBOUT], (float*)(ws + WS_SSQ)};
    pg8::gemm_phase<EpiResid, pg8::DenseOrder, false>(lds, 512, S, E);
}
template <int l> __device__ __forceinline__ void ph_moe1(const Args& args, LAS unsigned char* lds, const Ctx& c) {
    unsigned char* ws = args.ws;
    const int nbr = build_tables(args, lds, l);
    const char* bt0 = (const char*)(ws + WS_E13) + (size_t)l * NE1 * 512 * 1024;
    pg8::MoeOrder S; S.nunits = (nbr + 128) * 2; S.G = c.G; S.c = c.vcu; S.shift = 1; S.A = (const char*)(ws + WS_H); S.Bt = bt0;
    S.estride = (size_t)512 * 1024; S.btstep = (size_t)256 * 1024; S.atstep = 0; S.blk_e = (const LAS unsigned short*)(lds + LDS_BLKE_OFF); S.idx = (const LAS unsigned short*)(lds + LDS_IDX_OFF); S.gather = true;
    { const int* ST = (const int*)(ws + WS_SLOT_TOK); const float* SSA = (const float*)(ws + WS_SLOT_SA); const float* SB = (const float*)(ws + WS_SB13) + (size_t)l * NE1 * 512;
        LAS unsigned short* idx = (LAS unsigned short*)(lds + LDS_IDX_OFF); LAS float* sal = (LAS float*)(lds + LDS_SAL_OFF); LAS float* sbl = (LAS float*)(lds + LDS_SBL_OFF);
        int iv[11]; float fv[11];
#pragma unroll
        for (int i = 0; i < 11; ++i) { const int L = i * c.G + c.vcu; const bool ok = L < S.nunits; const int rb = ok ? (L >> 1) : 0, e = S.blk_e[rb]; iv[i] = 0; fv[i] = 0.f;
            if (c.tid < 256) { if (ok) { iv[i] = ST[(size_t)rb * 256 + c.tid]; fv[i] = SSA[(size_t)rb * 256 + c.tid]; } }
            else if (ok) fv[i] = SB[(size_t)e * 512 + (L & 1) * 256 + c.tid - 256]; }
#pragma unroll
        for (int i = 0; i < 11; ++i) { if (c.tid < 256) { idx[i * 256 + c.tid] = (unsigned short)iv[i]; sal[i * 256 + c.tid] = fv[i]; } else sbl[i * 256 + c.tid - 256] = fv[i]; } }
    __syncthreads();
    EpiMoe1 E{(unsigned char*)(ws + WS_HID), (const LAS float*)(lds + LDS_SAL_OFF), (const LAS float*)(lds + LDS_SBL_OFF)};
    pg8::gemm_phase<EpiMoe1, pg8::MoeOrder, true>(lds, 512, S, E);
}
template <int l> __device__ __forceinline__ void ph_moe2(const Args& args, LAS unsigned char* lds, const Ctx& c) {
    unsigned char* ws = args.ws;
    const int nbr = build_tables(args, lds, l);
    pg8::MoeOrder S; S.nunits = (nbr + 128) * 4; S.G = c.G; S.c = c.vcu; S.shift = 2; S.A = (const char*)(ws + WS_HID); S.Bt = (const char*)(ws + WS_E2) + (size_t)l * NE1 * 1024 * 256;
    S.estride = (size_t)1024 * 256; S.btstep = (size_t)256 * 256; S.atstep = (size_t)256 * 256; S.blk_e = (const LAS unsigned short*)(lds + LDS_BLKE_OFF); S.idx = nullptr; S.gather = false;
    { const float* SG = (const float*)(ws + WS_SLOT_GATE); LAS float* gl = (LAS float*)(lds + LDS_IDX_OFF);
        float gv[11]; const int hi = c.tid >> 8, t8 = c.tid & 255;
#pragma unroll
        for (int j = 0; j < 11; ++j) { const int L = (2 * j + hi) * c.G + c.vcu; gv[j] = (L < S.nunits) ? SG[(size_t)(L >> 2) * 256 + t8] : 0.f; }
#pragma unroll
        for (int j = 0; j < 11; ++j) gl[(2 * j + hi) * 256 + t8] = gv[j]; }
    __syncthreads();
    EpiMoe2 E{(unsigned char*)(ws + WS_Y), (const LAS float*)(lds + LDS_IDX_OFF)};
    pg8::gemm_phase<EpiMoe2, pg8::MoeOrder, false>(lds, 128, S, E);
}
#ifndef REPMASK
#define REPMASK 0
#endif
#ifndef PROBE_RT
#define PROBE_RT 0
#endif
#ifdef ONLY
#define PHON(id) ((id) == ONLY)
#else
#define PHON(id) true
#endif
#define RUN2(k, id, call, call2) do { if (PHON(id) && IN(k)) { if constexpr (((REPMASK >> (k)) & 1) != 0) { call2; __syncthreads(); } call; } } while (0)
#define RUN(k, id, call) do { if (PHON(id) && IN(k)) { call; if constexpr (((REPMASK >> (k)) & 1) != 0) { __syncthreads(); call; } } } while (0)
__global__ void __launch_bounds__(512, 2) fwd_kernel(Args args) {
    extern __shared__ __attribute__((aligned(16))) unsigned char lds_raw[];
    LAS unsigned char* lds = (LAS unsigned char*)lds_raw;
    Ctx c; c.tid = threadIdx.x; c.lane = c.tid & 63; c.wave = __builtin_amdgcn_readfirstlane(c.tid >> 6);
    c.G = gridDim.x; c.bid = blockIdx.x;
    c.vcu = (c.G % 8 == 0) ? (c.bid % 8) * (c.G / 8) + c.bid / 8 : c.bid;
    c.gw = c.bid * 8 + c.wave; c.NGW = c.G * 8;
    volatile LAS unsigned* MISC = (volatile LAS unsigned*)(lds + LDS_MISC_OFF);
    if (c.tid < 64) MISC[c.tid] = 0u;
    __syncthreads();
    unsigned* ctl = (unsigned*)(args.ws + WS_CTL);
    XcdBarrier bar = xcd_barrier_post(ctl + CW_BAR, MISC + 8);
    const int lo = args.ph_lo, hi = args.ph_hi;
#define IN(k) (lo <= (k) && (k) < hi)
#define SEAM(k, kn) do { if (IN(k) && IN(kn)) xcd_barrier(bar); } while (0)
    if (PHON(0) && IN(0)) {
#ifndef PROBE_P0
#define PROBE_P0 0
#endif
        for (int rep = 0; rep < ((PROBE_P0 == 1) ? 2 : 1); ++rep) { p0_mod(args, lds, c.tid, c.G, c.bid); p0_small(args, c.bid * 512 + c.tid, c.G * 512); __syncthreads(); }
        if (PROBE_P0 == 4) { p0_quant(args, lds, c.bid, c.G, args.ph_lo + 1); __syncthreads(); }
        for (int rep = 0; rep < ((PROBE_P0 == 2) ? 2 : 1); ++rep) { p0_quant(args, lds, c.bid, c.G, 0); __syncthreads(); }
        for (int rep = 0; rep < ((PROBE_P0 == 3) ? 2 : 1); ++rep) { p0_convert(args, lds, c.gw, c.NGW, c.wave, c.lane); __syncthreads(); }
    }
    SEAM(0, 1);
    if constexpr (((REPMASK >> 22) & 1) != 0) { for (int i = 0; i < 10; ++i) xcd_barrier(bar); }
    RUN(1, 1, p1_norm(args, c.gw, c.NGW, c.lane));
    SEAM(1, 2);
    RUN(2, 2, ph_inproj(args, lds, c));
    SEAM(2, 3);
    { int ob = c.bid; asm volatile("" : "+s"(ob));
      if constexpr (((REPMASK >> 3) & 1) != 0) { if (IN(3)) { attn_phase(args, lds, c.G, ob); __syncthreads(); } }
      if constexpr (((REPMASK >> 4) & 1) != 0) { if (IN(3)) { lru_phase<1>(args, lds, ob); __syncthreads(); } } }
    if (PHON(3) && IN(3)) { attn_phase(args, lds, c.G, c.vcu); lru_phase<1>(args, lds, c.vcu); }
    SEAM(3, 5);
    { int ob = c.bid; asm volatile("" : "+s"(ob));
      if constexpr (((REPMASK >> 5) & 1) != 0) { if (IN(5)) { lru_phase<2>(args, lds, ob); __syncthreads(); } } }
    if (PHON(5) && IN(5)) { lru_phase<2>(args, lds, c.vcu); }
    SEAM(5, 8);
    RUN(8, 8, ph_resid<0>(args, lds, c));
    SEAM(8, 9);
    RUN2(9, 9, router_phase(args, lds, 0, c.bid, c.G, 1), router_phase(args, lds, 0, c.bid, c.G, PROBE_RT));
    SEAM(9, 10);
    RUN(10, 10, slots_phase(args, lds, 0, c.bid));
    SEAM(10, 11);
    RUN(11, 11, ph_moe1<0>(args, lds, c));
    SEAM(11, 12);
    RUN(12, 12, ph_moe2<0>(args, lds, c));
    SEAM(12, 13);
    RUN(13, 13, combine_phase(args, 0, c.gw, c.NGW, c.lane));
    SEAM(13, 6);
    RUN(6, 6, ph_cin(args, lds, c));
    SEAM(6, 7);
    RUN(7, 7, conv_phase(args, lds, c.vcu, c.G));
    SEAM(7, 16);
    RUN(16, 8, ph_resid<1>(args, lds, c));
    SEAM(16, 17);
    RUN2(17, 9, router_phase(args, lds, 1, c.bid, c.G, 1), router_phase(args, lds, 1, c.bid, c.G, PROBE_RT));
    SEAM(17, 18);
    RUN(18, 10, slots_phase(args, lds, 1, c.bid));
    SEAM(18, 19);
    RUN(19, 11, ph_moe1<1>(args, lds, c));
    SEAM(19, 20);
    RUN(20, 12, ph_moe2<1>(args, lds, c));
    SEAM(20, 21);
    RUN(21, 13, combine_phase(args, 1, c.gw, c.NGW, c.lane));
#undef IN
#undef SEAM
}

constexpr int N_PHASES = 22;
extern "C" void kernel_launch(void* const* d_in, const int* in_sizes, int n_in, void* d_out, int out_size, void* d_ws, size_t ws_size, hipStream_t stream) {
    static int grid = 0;
    if (grid == 0) {
        if (n_in != 35 || in_sizes[0] != T * DM || out_size != T * DM || ws_size < WS_END) { fprintf(stderr, "kernel_launch: unexpected problem (n_in %d, in0 %d, out %d, ws %zu, need %zu); nothing launched\n", n_in, n_in > 0 ? in_sizes[0] : -1, out_size, ws_size, (size_t)WS_END); grid = -1; return; }
        int dev = 0, cus = 0, per_cu = 0;
        if (hipGetDevice(&dev) != hipSuccess || hipDeviceGetAttribute(&cus, hipDeviceAttributeMultiprocessorCount, dev) != hipSuccess) { grid = -1; return; }
        if (hipFuncSetAttribute((const void*)fwd_kernel, hipFuncAttributeMaxDynamicSharedMemorySize, LDS_BYTES) != hipSuccess) { fprintf(stderr, "kernel_launch: hipFuncSetAttribute failed\n"); grid = -1; return; }
        if (hipOccupancyMaxActiveBlocksPerMultiprocessor(&per_cu, (const void*)fwd_kernel, 512, LDS_BYTES) != hipSuccess || per_cu < 1) fprintf(stderr, "kernel_launch: occupancy query reports %d\n", per_cu);
        (void)hipGetLastError();
        grid = 256;
        if (cus < 256) { fprintf(stderr, "kernel_launch: %d CUs < 256: grid would not be resident; nothing launched\n", cus); grid = -1; return; }
    }
    if (grid < 0) return;
    if (hipMemsetAsync((char*)d_ws + WS_CTL, 0, CTL_ZERO_BYTES, stream) != hipSuccess) return;
    Args a{};
    for (int i = 0; i < 35; ++i) a.in[i] = (const float*)d_in[i];
    a.out = (float*)d_out; a.ws = (unsigned char*)d_ws; a.ph_lo = 0; a.ph_hi = N_PHASES;
    hipLaunchKernelGGL(fwd_kernel, dim3(grid), dim3(512), LDS_BYTES, stream, a);
}
```
